# Optimizing an MI355X kernel written in HIP

```python
import math
import jax, jax.numpy as jnp
from jax import lax
import numpy as np

D_MODEL = 2048
BATCH = 4
SEQ = 8192
DEPTH = 1

GDN_HEADS = 8
GDN_HEAD_DIM = 128
GDN_WIDTH = GDN_HEADS * GDN_HEAD_DIM
GDN_CONV = 4
GDN_CHUNK = 64
MOBA_HEADS = 8
MOBA_HEAD_DIM = 128
MOBA_WIDTH = MOBA_HEADS * MOBA_HEAD_DIM
MOBA_BLOCK = 256
MOBA_TOPK = 3
MOBA_Q_CHUNK = 16
REL_BUCKETS = 32
REL_MAX_DIST = 2048
D_FF = ((8 * D_MODEL // 3 + 255) // 256) * 256
PROJ_SPLITS = (GDN_WIDTH,) * 4 + (GDN_HEADS,) * 2 + (MOBA_WIDTH,) * 3 + (D_MODEL,) * 2
D_PROJ = sum(PROJ_SPLITS)
RMS_EPS = 1e-6
NEG_INF = -1e30

kernel_name = 'hybrid_gdn_moba_gated_block'


def _rmsnorm(x, w):
    x32 = x.astype(jnp.float32)
    y = x32 * lax.rsqrt(jnp.mean(x32 * x32, axis=-1, keepdims=True) + RMS_EPS)
    return (y * w.astype(jnp.float32)).astype(x.dtype)


def _l2norm(x):
    return x * lax.rsqrt(jnp.sum(x * x, axis=-1, keepdims=True) + RMS_EPS)


def _causal_short_conv(u, w):
    K = w.shape[0]
    T = u.shape[1]
    up = jnp.pad(u, ((0, 0), (K - 1, 0), (0, 0)))
    y = up[:, 0:T] * w[0]
    for j in range(1, K):
        y = y + up[:, j:j + T] * w[j]
    return jax.nn.silu(y)


def _chunk_gated_delta_rule(q, k, v, g, beta):
    B, H, T, Dk = q.shape
    Dv = v.shape[-1]
    C = GDN_CHUNK
    N = T // C
    q = q * (Dk ** -0.5)
    q, k, v = (t.reshape(B, H, N, C, t.shape[-1]) for t in (q, k, v))
    g = jnp.cumsum(g.reshape(B, H, N, C), axis=-1)
    beta = beta.reshape(B, H, N, C)
    incl = jnp.tril(jnp.ones((C, C), dtype=bool))
    strict = jnp.tril(jnp.ones((C, C), dtype=bool), k=-1)
    diff = g[..., :, None] - g[..., None, :]
    decay = jnp.where(incl, jnp.exp(jnp.where(incl, diff, 0.0)), 0.0)
    k_beta = k * beta[..., None]
    L = jnp.where(strict, jnp.einsum('bhnik,bhnjk->bhnij', k_beta, k) * decay, 0.0)
    eye = jnp.eye(C, dtype=q.dtype)
    rhs = jnp.concatenate([k_beta * jnp.exp(g)[..., None], v * beta[..., None]], axis=-1)
    wu = lax.linalg.triangular_solve(eye + L, rhs, left_side=True, lower=True)
    w, u = wu[..., :Dk], wu[..., Dk:]
    A = jnp.where(incl, jnp.einsum('bhnik,bhnjk->bhnij', q, k) * decay, 0.0)
    g_last = g[..., -1]
    q_dec = q * jnp.exp(g)[..., None]
    k_dec = k * jnp.exp(g_last[..., None] - g)[..., None]
    xs = tuple(jnp.moveaxis(t, 2, 0) for t in (q_dec, k_dec, w, u, A, g_last))

    def step(S, inp):
        q_n, k_n, w_n, u_n, A_n, gl_n = inp
        v_new = u_n - jnp.einsum('bhck,bhkv->bhcv', w_n, S)
        o_n = jnp.einsum('bhck,bhkv->bhcv', q_n, S) + jnp.einsum('bhcs,bhsv->bhcv', A_n, v_new)
        S = S * jnp.exp(gl_n)[..., None, None] + jnp.einsum('bhck,bhcv->bhkv', k_n, v_new)
        return S, o_n

    S0 = jnp.zeros((B, H, Dk, Dv), q.dtype)
    _, o = lax.scan(step, S0, xs)
    return jnp.moveaxis(o, 0, 2).reshape(B, H, T, Dv)


def _gated_deltanet(q, k, v, z, beta_logit, a_logit, conv_w, a_log, dt_bias, o_norm_w):
    B, T, _ = q.shape
    H, Dh = GDN_HEADS, GDN_HEAD_DIM
    f32 = jnp.float32
    qkv = _causal_short_conv(jnp.concatenate([q, k, v], axis=-1), conv_w).astype(f32)
    q, k, v = (t.reshape(B, T, H, Dh).transpose(0, 2, 1, 3) for t in jnp.split(qkv, 3, axis=-1))
    q = _l2norm(q)
    k = _l2norm(k)
    beta = jax.nn.sigmoid(beta_logit.astype(f32)).transpose(0, 2, 1)
    g = -jnp.exp(a_log.astype(f32)) * jax.nn.softplus(a_logit.astype(f32) + dt_bias.astype(f32))
    g = g.transpose(0, 2, 1)
    o = _chunk_gated_delta_rule(q, k, v, g, beta).transpose(0, 2, 1, 3)
    o = _rmsnorm(o, o_norm_w) * jax.nn.silu(z.astype(f32).reshape(B, T, H, Dh))
    return o.reshape(B, T, H * Dh).astype(z.dtype)


def _t5_bucket(dist):
    max_exact = REL_BUCKETS // 2
    d = dist.astype(jnp.float32)
    log_ratio = jnp.log(jnp.maximum(d, float(max_exact)) / max_exact) / math.log(REL_MAX_DIST / max_exact)
    large = max_exact + (log_ratio * (REL_BUCKETS - max_exact)).astype(jnp.int32)
    large = jnp.minimum(large, REL_BUCKETS - 1)
    return jnp.where(dist < max_exact, dist, large)


def _moba_attention(q, k, v, q_norm_w, k_norm_w, rel_bias):
    B, T, _ = q.shape
    H, Dh, BS, QC = MOBA_HEADS, MOBA_HEAD_DIM, MOBA_BLOCK, MOBA_Q_CHUNK
    out_dtype = q.dtype

    def heads(t):
        return t.astype(jnp.float32).reshape(B, T, H, Dh).transpose(0, 2, 1, 3)

    q = _rmsnorm(heads(q), q_norm_w)
    k = _rmsnorm(heads(k), k_norm_w)
    v = heads(v)
    Tp = -(-T // BS) * BS
    pad = ((0, 0), (0, 0), (0, Tp - T), (0, 0))
    q, k, v = (jnp.pad(t, pad) for t in (q, k, v))
    NB = Tp // BS
    topk = min(MOBA_TOPK, NB)
    k_blocks = k.reshape(B, H, NB, BS, Dh)
    v_blocks = v.reshape(B, H, NB, BS, Dh)
    k_mean = jnp.mean(k_blocks, axis=3)
    route = jnp.einsum('bhtd,bhnd->bhtn', q, k_mean)
    q_block = jnp.arange(Tp) // BS
    fully_past = jnp.arange(NB)[None, :] < q_block[:, None]
    route = jnp.where(fully_past, route, NEG_INF)
    _, sel = lax.top_k(route, topk)
    n_qc = Tp // QC
    q_c = jnp.moveaxis(q.reshape(B, H, n_qc, QC, Dh), 2, 0)
    sel_c = jnp.moveaxis(sel.reshape(B, H, n_qc, QC, topk), 2, 0)
    rel_t = rel_bias.astype(jnp.float32).T
    b_idx = jnp.arange(B)[:, None, None, None]
    h_idx = jnp.arange(H)[None, :, None, None]
    scale = Dh ** -0.5
    offs = jnp.arange(BS)

    def attend(args):
        c, q_n, sel_n = args
        q_pos = c * QC + jnp.arange(QC)
        blk = (c * QC) // BS
        k_own = lax.dynamic_index_in_dim(k_blocks, blk, axis=2, keepdims=False)
        v_own = lax.dynamic_index_in_dim(v_blocks, blk, axis=2, keepdims=False)
        dist_own = q_pos[:, None] - (blk * BS + offs)[None, :]
        s_own = jnp.einsum('bhqd,bhkd->bhqk', q_n, k_own) * scale + rel_t[:, _t5_bucket(jnp.maximum(dist_own, 0))][None]
        s_own = jnp.where(dist_own >= 0, s_own, NEG_INF)
        k_sel = k_blocks[b_idx, h_idx, sel_n]
        v_sel = v_blocks[b_idx, h_idx, sel_n]
        dist_sel = q_pos[None, None, :, None, None] - (sel_n[..., None] * BS + offs)
        s_sel = jnp.einsum('bhqd,bhqnkd->bhqnk', q_n, k_sel) * scale + rel_t[h_idx[..., None], _t5_bucket(jnp.maximum(dist_sel, 0))]
        s_sel = jnp.where((sel_n < blk)[..., None], s_sel, NEG_INF)
        logits = jnp.concatenate([s_own, s_sel.reshape(B, H, QC, topk * BS)], axis=-1)
        p = jax.nn.softmax(logits, axis=-1)
        p_own = p[..., :BS]
        p_sel = p[..., BS:].reshape(B, H, QC, topk, BS)
        return jnp.einsum('bhqk,bhkd->bhqd', p_own, v_own) + jnp.einsum('bhqnk,bhqnkd->bhqd', p_sel, v_sel)

    o = lax.map(attend, (jnp.arange(n_qc), q_c, sel_c))
    o = jnp.moveaxis(o, 0, 2).reshape(B, H, Tp, Dh)[:, :, :T]
    return o.transpose(0, 2, 1, 3).reshape(B, T, H * Dh).astype(out_dtype)


def setup_inputs(seed: int = 0) -> dict:
    key = jax.random.key(seed)
    ks = jax.random.split(key, 17)
    f32 = jnp.float32

    def normal(k, shape, fan_in):
        return jax.random.normal(k, shape, f32) * fan_in ** -0.5

    def gain(k, shape):
        return 1.0 + 0.1 * jax.random.normal(k, shape, f32)

    x = jax.random.normal(ks[0], (BATCH, SEQ, D_MODEL), f32)
    norm_mix_w = gain(ks[1], (DEPTH, D_MODEL))
    w_in = normal(ks[2], (DEPTH, D_MODEL, D_PROJ), D_MODEL)
    conv_w = normal(ks[3], (DEPTH, GDN_CONV, 3 * GDN_WIDTH), GDN_CONV)
    a_log = jnp.log(jax.random.uniform(ks[4], (DEPTH, GDN_HEADS), f32, 1.0, 16.0))
    dt = jnp.exp(jax.random.uniform(ks[5], (DEPTH, GDN_HEADS), f32, math.log(1e-3), math.log(1e-1)))
    dt_bias = dt + jnp.log(-jnp.expm1(-dt))
    gdn_o_norm_w = gain(ks[6], (DEPTH, GDN_HEAD_DIM))
    q_norm_w = gain(ks[7], (DEPTH, MOBA_HEAD_DIM))
    k_norm_w = gain(ks[8], (DEPTH, MOBA_HEAD_DIM))
    rel_bias = 0.5 * jax.random.normal(ks[9], (REL_BUCKETS, MOBA_HEADS), f32)
    w_branch_gdn = normal(ks[10], (DEPTH, GDN_WIDTH, D_MODEL), GDN_WIDTH)
    w_branch_moba = normal(ks[11], (DEPTH, MOBA_WIDTH, D_MODEL), MOBA_WIDTH)
    w_out = normal(ks[12], (DEPTH, D_MODEL, D_MODEL), D_MODEL)
    norm_ffn_w = gain(ks[13], (DEPTH, D_MODEL))
    w_ffn_gate = normal(ks[14], (DEPTH, D_MODEL, D_FF), D_MODEL)
    w_ffn_up = normal(ks[15], (DEPTH, D_MODEL, D_FF), D_MODEL)
    w_ffn_down = normal(ks[16], (DEPTH, D_FF, D_MODEL), D_FF)
    return {'x': x, 'norm_mix_w': norm_mix_w, 'w_in': w_in, 'conv_w': conv_w, 'a_log': a_log,
            'dt_bias': dt_bias, 'gdn_o_norm_w': gdn_o_norm_w, 'q_norm_w': q_norm_w, 'k_norm_w': k_norm_w,
            'rel_bias': rel_bias, 'w_branch_gdn': w_branch_gdn, 'w_branch_moba': w_branch_moba,
            'w_out': w_out, 'norm_ffn_w': norm_ffn_w, 'w_ffn_gate': w_ffn_gate, 'w_ffn_up': w_ffn_up,
            'w_ffn_down': w_ffn_down}


def reference(x, norm_mix_w, w_in, conv_w, a_log, dt_bias, gdn_o_norm_w, q_norm_w, k_norm_w,
              rel_bias, w_branch_gdn, w_branch_moba, w_out, norm_ffn_w, w_ffn_gate, w_ffn_up, w_ffn_down):
    split_at = np.cumsum(PROJ_SPLITS)[:-1].tolist()
    h = x
    for l in range(DEPTH):
        u = _rmsnorm(h, norm_mix_w[l])
        proj = jnp.einsum('btd,de->bte', u, w_in[l])
        (q_a, k_a, v_a, z_a, beta_a, dec_a, q_b, k_b, v_b, gate_a, gate_b) = jnp.split(proj, split_at, axis=-1)
        y_a = _gated_deltanet(q_a, k_a, v_a, z_a, beta_a, dec_a, conv_w[l], a_log[l], dt_bias[l], gdn_o_norm_w[l])
        y_b = _moba_attention(q_b, k_b, v_b, q_norm_w[l], k_norm_w[l], rel_bias)
        mix = (jax.nn.sigmoid(gate_a) * jnp.einsum('btc,cd->btd', y_a, w_branch_gdn[l])
               + jax.nn.sigmoid(gate_b) * jnp.einsum('btc,cd->btd', y_b, w_branch_moba[l]))
        h = h + jnp.einsum('btd,de->bte', mix, w_out[l])
        u = _rmsnorm(h, norm_ffn_w[l])
        hid = jax.nn.silu(jnp.einsum('btd,df->btf', u, w_ffn_gate[l])) * jnp.einsum('btd,df->btf', u, w_ffn_up[l])
        h = h + jnp.einsum('btf,fd->btd', hid, w_ffn_down[l])
    return h
```

```cpp
#include <hip/hip_runtime.h>
#include <hip/hip_cooperative_groups.h>
#include <cstdio>
#include <cstdint>
namespace cg = cooperative_groups;


#ifndef LAUNCH_PROG
#define LAUNCH_PROG {{0, 9, 0}}
#endif
constexpr int NB = 4, NT = 8192, DM = 2048, NH = 8, HD = 128, MTOK = NB * NT;
constexpr int DFF = 5632, NPROJ = 11264, WIN_LD = 11280;
constexpr size_t SEC = (size_t)MTOK * 1024;
constexpr size_t SECB = SEC * 2;
constexpr size_t WS_WIN = 0;
constexpr size_t WS_WBG = WS_WIN + (size_t)NPROJ * DM * 2;
constexpr size_t WS_WBM = WS_WBG + (size_t)DM * 1024 * 2;
constexpr size_t WS_WOUT = WS_WBM + (size_t)DM * 1024 * 2;
constexpr size_t WS_WGU = WS_WOUT + (size_t)DM * DM * 2;
constexpr size_t WS_WDN = WS_WGU + (size_t)NPROJ * DM * 2;
constexpr size_t WS_MISC = WS_WDN + (size_t)DM * DFF * 2;
constexpr size_t WS_CNT = WS_MISC + (size_t)MTOK * 4;
constexpr size_t WS_PROJ = 2 * SECB;
constexpr size_t WS_T0 = 13 * SECB, WS_T1 = 14 * SECB, WS_T2 = 15 * SECB;
static_assert(WS_CNT + 4096 <= WS_PROJ, "weights + misc fit under proj");
constexpr size_t REC_BYTES = 57344;
constexpr size_t DO_SMALL = (size_t)4096 * REC_BYTES;
constexpr size_t DO_BETA = DO_SMALL, DO_G = DO_BETA + (1u << 20), DO_ML = DO_G + (1u << 20), DO_SEL = DO_ML + (8u << 20),
                 DO_KMEAN = DO_SEL + (1u << 20), DO_BIAS = DO_KMEAN + (512u << 10), DO_GL = DO_BIAS + (256u << 10);
static_assert(DO_GL + 16384 <= (size_t)MTOK * DM * 4, "small stuff fits in d_out");
constexpr int LDS_BYTES = 153600;
constexpr float RMS_EPS = 1e-6f;

typedef unsigned short bf16_t;
typedef short bf16x8 __attribute__((ext_vector_type(8)));
typedef float f32x4 __attribute__((ext_vector_type(4)));
typedef float f32x16 __attribute__((ext_vector_type(16)));
typedef unsigned u32x4 __attribute__((ext_vector_type(4)));
typedef unsigned u32x2 __attribute__((ext_vector_type(2)));

__device__ __forceinline__ unsigned cvt_pk_bf16(float lo, float hi) { unsigned r; asm volatile("v_cvt_pk_bf16_f32 %0, %1, %2" : "=v"(r) : "v"(lo), "v"(hi)); return r; }
__device__ __forceinline__ float bflo(unsigned w) { return __uint_as_float(w << 16); }
__device__ __forceinline__ float bfhi(unsigned w) { return __uint_as_float(w & 0xffff0000u); }
__device__ __forceinline__ float bf1(bf16_t b) { return __uint_as_float((unsigned)b << 16); }
__device__ __forceinline__ unsigned f2bf(float f) { unsigned u = __float_as_uint(f); return (u + 0x7fffu + ((u >> 16) & 1u)) >> 16; }
__device__ __forceinline__ float sigmoidf_(float x) { return __builtin_amdgcn_rcpf(1.f + __expf(-x)); }
__device__ __forceinline__ float siluf_(float x) { return x * __builtin_amdgcn_rcpf(1.f + __expf(-x)); }
__device__ __forceinline__ int perm16(int p) { return (p & 3) + ((p >> 2) & 1) * 8 + ((p >> 3) & 1) * 4; }
__device__ __forceinline__ float wave_sum(float v) {
#pragma unroll
    for (int o = 1; o < 64; o <<= 1) v += __shfl_xor(v, o);
    return v;
}
#define LDS_WAIT() asm volatile("s_waitcnt lgkmcnt(0)" ::: "memory")
struct Params { const float* in[17]; float* out; unsigned char* ws; int ph_lo, ph_hi, flags, pad; };
namespace pg8 {
#define PG8_LAS __attribute__((address_space(3)))
typedef unsigned short bf16_t;
typedef short bf16x8 __attribute__((ext_vector_type(8)));
typedef float f32x4 __attribute__((ext_vector_type(4)));
typedef unsigned u32x4 __attribute__((ext_vector_type(4)));
constexpr int BM = 256, BK = 64, HALF = 128, HTB = HALF * BK * 2  , STAGE_BYTES = 8 * HTB, NXCD = 8, WGM = 8;

__host__ __device__ __forceinline__ int lds_byte(int r, int c) { const int st = (r >> 4) * 2 + (c >> 5), rr = r & 15, cc = c & 31, ob = rr * 64 + cc * 2; return st * 1024 + (ob ^ (((ob >> 9) & 1) << 5)); }
__host__ __device__ __forceinline__ void stage_rc(int b, int& R, int& C) { const int st = b / 1024, sb = b % 1024, swz = sb ^ (((sb >> 9) & 1) << 5); R = (st >> 1) * 16 + swz / 64; C = (st & 1) * 32 + (swz % 64) / 2; }
__host__ __device__ __forceinline__ int perm32(int rho) { const int n = rho >> 4, i = rho & 15; return 8 * (i >> 2) + 4 * n + (i & 3); }

struct Unit { int pm, pn; };
struct Gemm { const bf16_t* A; const bf16_t* Bt; int M, N, K; };

struct StaticOrder {
    int nM, nN, nwg, G, c;
    __host__ __device__ void init(int M, int N, int G_, int c_) { nM = M / BM; nN = N / BM; nwg = nM * nN; G = G_; c = c_; }
    __host__ __device__ bool next(int i, Unit& u) const {
        const long L = (long)i * G + c; if (L >= nwg) return false;
        int wgid = (int)L; { const int q = nwg / NXCD, r = nwg % NXCD, xcd = wgid % NXCD, off = wgid / NXCD; wgid = (xcd < r ? xcd * (q + 1) : r * (q + 1) + (xcd - r) * q) + off; }
        const int nig = WGM * nN, gid = wgid / nig, fm = gid * WGM, gsz = (nM - fm) < WGM ? (nM - fm) : WGM;
        u.pm = fm + ((wgid % nig) % gsz); u.pn = (wgid % nig) / gsz; return true;
    }
    __device__ __forceinline__ void a_ready(const Unit&) const {}
    __device__ __forceinline__ void done(const Unit&) const {}
};

struct EpiSplit {
    static constexpr bool PERM = true, AFTER_DRAIN = false, MID = false;
    bf16_t* O;
    __device__ __forceinline__ void operator()(const f32x4 (&acc)[2][2][4][2], const Unit& u, int wr, int wc, int fr, int fq) const {
        const int row0 = u.pm * BM + wr * 64 + fr; int colt = u.pn * BM; const int sec = colt >> 10; colt &= 1023;
        bf16_t* base = O + (size_t)sec * SEC; const int col0 = colt + wc * 32 + 8 * fq;
#pragma unroll
        for (int ai = 0; ai < 2; ++ai)
#pragma unroll
            for (int m = 0; m < 4; ++m) { bf16_t* rowp = base + (size_t)(row0 + ai * HALF + m * 16) * 1024 + col0;
#pragma unroll
                for (int bj = 0; bj < 2; ++bj) { const f32x4 v0 = acc[ai][bj][m][0], v1 = acc[ai][bj][m][1];
                    u32x4 w; w.x = cvt_pk_bf16(v0[0], v0[1]); w.y = cvt_pk_bf16(v0[2], v0[3]); w.z = cvt_pk_bf16(v1[0], v1[1]); w.w = cvt_pk_bf16(v1[2], v1[3]);
                    *(u32x4*)(rowp + bj * HALF) = w; } }
    }
};
struct EpiGateMix {
    static constexpr bool PERM = true, AFTER_DRAIN = false, MID = true;
    const bf16_t* gate; bf16_t* mix;
    static __device__ __forceinline__ float cl(float x) { return fminf(fmaxf(x, -30.f), 30.f); }
    __device__ __forceinline__ void mid(f32x4 (&acc)[2][2][4][2], const Unit& u, int wr, int wc, int fr, int fq) const {
        int fro = fr; asm volatile("" : "+v"(fro));
        const int row0 = u.pm * BM + wr * 64 + fro;
#pragma unroll
        for (int ai = 0; ai < 2; ++ai)
#pragma unroll
            for (int m = 0; m < 4; ++m) { const size_t row = (size_t)(row0 + ai * HALF + m * 16);
#pragma unroll
                for (int bj = 0; bj < 2; ++bj) { const int col = u.pn * BM + bj * HALF + wc * 32 + 8 * fq;
                    const bf16_t* gp = gate + (size_t)(col >> 10) * SEC + row * 1024 + (col & 1023);
                    const u32x4 ga = *(const u32x4*)gp, gb = *(const u32x4*)(gp + 2 * SEC);
                    float ea[8] = {bflo(ga.x), bfhi(ga.x), bflo(ga.y), bfhi(ga.y), bflo(ga.z), bfhi(ga.z), bflo(ga.w), bfhi(ga.w)};
                    float eb[8] = {bflo(gb.x), bfhi(gb.x), bflo(gb.y), bfhi(gb.y), bflo(gb.z), bfhi(gb.z), bflo(gb.w), bfhi(gb.w)};
                    float r[8];
#pragma unroll
                    for (int e = 0; e < 8; ++e) r[e] = (1.f + __expf(-cl(eb[e]))) * __builtin_amdgcn_rcpf(1.f + __expf(-cl(ea[e])));
                    acc[ai][bj][m][0][0] *= r[0]; acc[ai][bj][m][0][1] *= r[1]; acc[ai][bj][m][0][2] *= r[2]; acc[ai][bj][m][0][3] *= r[3];
                    acc[ai][bj][m][1][0] *= r[4]; acc[ai][bj][m][1][1] *= r[5]; acc[ai][bj][m][1][2] *= r[6]; acc[ai][bj][m][1][3] *= r[7]; }
                if (m == 3) __builtin_amdgcn_sched_barrier(0); }
    }
    __device__ __forceinline__ void operator()(const f32x4 (&acc)[2][2][4][2], const Unit& u, int wr, int wc, int fr, int fq) const {
        const int row0 = u.pm * BM + wr * 64 + fr;
#pragma unroll
        for (int ai = 0; ai < 2; ++ai)
#pragma unroll
            for (int m = 0; m < 4; ++m) { const size_t row = (size_t)(row0 + ai * HALF + m * 16);
#pragma unroll
                for (int bj = 0; bj < 2; ++bj) { const int col = u.pn * BM + bj * HALF + wc * 32 + 8 * fq;
                    const u32x4 gw = *(const u32x4*)(gate + (size_t)(2 + (col >> 10)) * SEC + row * 1024 + (col & 1023));
                    const f32x4 v0 = acc[ai][bj][m][0], v1 = acc[ai][bj][m][1];
                    float r[8];
                    r[0] = v0[0] * sigmoidf_(cl(bflo(gw.x))); r[1] = v0[1] * sigmoidf_(cl(bfhi(gw.x))); r[2] = v0[2] * sigmoidf_(cl(bflo(gw.y))); r[3] = v0[3] * sigmoidf_(cl(bfhi(gw.y)));
                    r[4] = v1[0] * sigmoidf_(cl(bflo(gw.z))); r[5] = v1[1] * sigmoidf_(cl(bfhi(gw.z))); r[6] = v1[2] * sigmoidf_(cl(bflo(gw.w))); r[7] = v1[3] * sigmoidf_(cl(bfhi(gw.w)));
                    u32x4 w; w.x = cvt_pk_bf16(r[0], r[1]); w.y = cvt_pk_bf16(r[2], r[3]); w.z = cvt_pk_bf16(r[4], r[5]); w.w = cvt_pk_bf16(r[6], r[7]);
                    *(u32x4*)(mix + row * 2048 + col) = w; } }
    }
};
struct EpiH1 {
    static constexpr bool PERM = true, AFTER_DRAIN = false, MID = false;
    const float* x; float* h1; bf16_t* h1b; float* rowsq;
    __device__ __forceinline__ void operator()(const f32x4 (&acc)[2][2][4][2], const Unit& u, int wr, int wc, int fr, int fq) const {
        const int row0 = u.pm * BM + wr * 64 + fr;
#pragma unroll
        for (int ai = 0; ai < 2; ++ai)
#pragma unroll
            for (int m = 0; m < 4; ++m) { const size_t row = (size_t)(row0 + ai * HALF + m * 16); float ss = 0.f;
#pragma unroll
                for (int bj = 0; bj < 2; ++bj) { const int col = u.pn * BM + bj * HALF + wc * 32 + 8 * fq;
                    const float* xp = x + row * 2048 + col; float* hp = h1 + row * 2048 + col;
                    const f32x4 a0 = *(const f32x4*)xp + acc[ai][bj][m][0], a1 = *(const f32x4*)(xp + 4) + acc[ai][bj][m][1];
                    *(f32x4*)hp = a0; *(f32x4*)(hp + 4) = a1;
                    ss += a0[0] * a0[0] + a0[1] * a0[1] + a0[2] * a0[2] + a0[3] * a0[3] + a1[0] * a1[0] + a1[1] * a1[1] + a1[2] * a1[2] + a1[3] * a1[3];
                    u32x4 w; w.x = cvt_pk_bf16(a0[0], a0[1]); w.y = cvt_pk_bf16(a0[2], a0[3]); w.z = cvt_pk_bf16(a1[0], a1[1]); w.w = cvt_pk_bf16(a1[2], a1[3]);
                    *(u32x4*)(h1b + row * 2048 + col) = w; }
                ss += __shfl_xor(ss, 16); ss += __shfl_xor(ss, 32);
                if (fq == 0) atomicAdd(rowsq + row, ss); }
    }
};
struct EpiSwiGLU {
    static constexpr bool PERM = true, AFTER_DRAIN = false, MID = false;
    const float* rowsq; bf16_t* hid;
    __device__ __forceinline__ void operator()(const f32x4 (&acc)[2][2][4][2], const Unit& u, int wr, int wc, int fr, int fq) const {
        const int row0 = u.pm * BM + wr * 64 + fr; const int col = u.pn * HALF + wc * 32 + 8 * fq;
#pragma unroll
        for (int ai = 0; ai < 2; ++ai)
#pragma unroll
            for (int m = 0; m < 4; ++m) { const size_t row = (size_t)(row0 + ai * HALF + m * 16);
                const float rstd = rsqrtf(rowsq[row] * (1.f / 2048.f) + RMS_EPS);
                float r[8];
#pragma unroll
                for (int n = 0; n < 2; ++n)
#pragma unroll
                    for (int e = 0; e < 4; ++e) { const float g = acc[ai][0][m][n][e] * rstd, up = acc[ai][1][m][n][e] * rstd; r[n * 4 + e] = siluf_(g) * up; }
                u32x4 w; w.x = cvt_pk_bf16(r[0], r[1]); w.y = cvt_pk_bf16(r[2], r[3]); w.z = cvt_pk_bf16(r[4], r[5]); w.w = cvt_pk_bf16(r[6], r[7]);
                *(u32x4*)(hid + row * DFF + col) = w; }
    }
};
struct EpiDown {
    static constexpr bool PERM = true, AFTER_DRAIN = false, MID = false;
    float* out;
    __device__ __forceinline__ void operator()(const f32x4 (&acc)[2][2][4][2], const Unit& u, int wr, int wc, int fr, int fq) const {
        const int row0 = u.pm * BM + wr * 64 + fr;
#pragma unroll
        for (int ai = 0; ai < 2; ++ai)
#pragma unroll
            for (int m = 0; m < 4; ++m) { const size_t row = (size_t)(row0 + ai * HALF + m * 16);
#pragma unroll
                for (int bj = 0; bj < 2; ++bj) { const int col = u.pn * BM + bj * HALF + wc * 32 + 8 * fq; float* op = out + row * 2048 + col;
                    const f32x4 a0 = *(const f32x4*)op + acc[ai][bj][m][0], a1 = *(const f32x4*)(op + 4) + acc[ai][bj][m][1];
                    *(f32x4*)op = a0; *(f32x4*)(op + 4) = a1; } }
    }
};
template <class Epi, class Sched, bool ALIGN_EPI = false, bool SP2 = false>
__device__ __forceinline__ void gemm_phase(PG8_LAS unsigned char* lds, const Gemm g, const Sched& S, const Epi& E) {
    const int tid = threadIdx.x, wid = __builtin_amdgcn_readfirstlane(tid >> 6), lane = tid & 63, wr = wid >> 2, wc = wid & 3, fr = lane & 15, fq = lane >> 4;
    const int K = g.K, nt = K / BK;
    unsigned voffA[2], voffB[2];
#pragma unroll
    for (int i = 0; i < 2; ++i) { int R, C; stage_rc(tid * 16 + i * 8192, R, C); const int Rb = Epi::PERM ? ((R & ~31) + perm32(R & 31)) : R;
        voffA[i] = (unsigned)(R * K + C) * 2u; voffB[i] = (unsigned)(Rb * K + C) * 2u; }
    const size_t kstep = (size_t)(BK * 2);
    const size_t hstep = (size_t)HALF * K * 2;
    const size_t tstep = 2 * hstep;
    const unsigned ldsw = (unsigned)wid * 1024u;
    const int aoff = lds_byte(wr * 64 + fr, fq * 8), boff = lds_byte(wc * 32 + fr, fq * 8);
#define PG8_SA(b, h) (((b) * 2 + (h)) * HTB)
#define PG8_SB(b, h) ((4 + (b) * 2 + (h)) * HTB)
#define PG8_STAGE(bufoff, gbase, voff) do { _Pragma("unroll") for (int _i = 0; _i < 2; ++_i) \
        __builtin_amdgcn_global_load_lds((const unsigned*)((const char*)(gbase) + (voff)[_i]), (PG8_LAS unsigned*)(lds + (bufoff) + ldsw + _i * 8192), 16, 0, 0); } while (0)
#define PG8_LDA(dst, b, h) do { _Pragma("unroll") for (int m = 0; m < 4; ++m) _Pragma("unroll") for (int k = 0; k < 2; ++k) dst[m][k] = *(const PG8_LAS bf16x8*)(lds + PG8_SA(b, h) + aoff + m * 2048 + k * 1024); } while (0)
#define PG8_LDB(dst, b, h) do { _Pragma("unroll") for (int n = 0; n < 2; ++n) _Pragma("unroll") for (int k = 0; k < 2; ++k) dst[n][k] = *(const PG8_LAS bf16x8*)(lds + PG8_SB(b, h) + boff + n * 2048 + k * 1024); } while (0)
#define PG8_MMA(ai, bj, At, Bt) do { __builtin_amdgcn_s_setprio(1); _Pragma("unroll") for (int m = 0; m < 4; ++m) _Pragma("unroll") for (int n = 0; n < 2; ++n) _Pragma("unroll") for (int k = 0; k < 2; ++k) \
        acc[ai][bj][m][n] = __builtin_amdgcn_mfma_f32_16x16x32_bf16(Bt[n][k], At[m][k], acc[ai][bj][m][n], 0, 0, 0); __builtin_amdgcn_s_setprio(0); } while (0)
#define PG8_WAIT_V(n) asm volatile("s_waitcnt vmcnt(" #n ")" ::: "memory")
#define PG8_WAIT_L(n) asm volatile("s_waitcnt lgkmcnt(" #n ")" ::: "memory")
#define PG8_BAR __builtin_amdgcn_s_barrier()
#define PG8_SCHED __builtin_amdgcn_sched_barrier(0)
    Unit cur, nxt; int ui = 0;
    if (!S.next(0, cur)) return;
    f32x4 acc[2][2][4][2];
#pragma unroll
    for (int a = 0; a < 2; ++a)
#pragma unroll
        for (int b = 0; b < 2; ++b)
#pragma unroll
            for (int m = 0; m < 4; ++m)
#pragma unroll
                for (int n = 0; n < 2; ++n) acc[a][b][m][n] = (f32x4){0.f, 0.f, 0.f, 0.f};
    bf16x8 At[4][2], B0[2][2], B1[2][2];
    const char* cA = (const char*)g.A + (size_t)cur.pm * tstep; const char* cB = (const char*)g.Bt + (size_t)cur.pn * tstep;
    S.a_ready(cur);
    if constexpr (SP2) {
        PG8_STAGE(PG8_SB(0, 0), cB, voffB); PG8_STAGE(PG8_SB(0, 1), cB + hstep, voffB); PG8_STAGE(PG8_SA(0, 0), cA, voffA); PG8_STAGE(PG8_SA(0, 1), cA + hstep, voffA);
        if (wr == 1) PG8_BAR;
        PG8_WAIT_V(2); PG8_BAR;
        PG8_STAGE(PG8_SB(1, 0), cB + kstep, voffB); PG8_STAGE(PG8_SA(1, 0), cA + kstep, voffA); PG8_STAGE(PG8_SB(1, 1), cB + hstep + kstep, voffB);
        PG8_WAIT_V(6); PG8_BAR;
    } else {
        PG8_STAGE(PG8_SB(0, 0), cB, voffB); PG8_STAGE(PG8_SA(0, 0), cA, voffA); PG8_STAGE(PG8_SB(0, 1), cB + hstep, voffB); PG8_STAGE(PG8_SA(0, 1), cA + hstep, voffA);
        if (wr == 1) PG8_BAR;
        PG8_WAIT_V(4); PG8_BAR;
        PG8_STAGE(PG8_SB(1, 0), cB + kstep, voffB); PG8_STAGE(PG8_SA(1, 0), cA + kstep, voffA); PG8_STAGE(PG8_SB(1, 1), cB + hstep + kstep, voffB);
        PG8_WAIT_V(6); PG8_BAR;
    }
    for (;;) {
        const bool has_next = S.next(ui + 1, nxt);
        const char* nA = has_next ? (const char*)g.A + (size_t)nxt.pm * tstep : cA; const char* nB = has_next ? (const char*)g.Bt + (size_t)nxt.pn * tstep : cB;
        for (int t = 0; t < nt; t += 2) {
            const bool last = (t == nt - 2);
            const char* a1 = cA + (size_t)(t + 1) * kstep;
            const char* a2 = last ? nA : cA + (size_t)(t + 2) * kstep; const char* b2 = last ? nB : cB + (size_t)(t + 2) * kstep;
            const char* a3 = a2 + kstep; const char* b3 = b2 + kstep;
            if (last && has_next) S.a_ready(nxt);
            if constexpr (Epi::MID) { if (t == (nt >> 1)) E.mid(acc, cur, wr, wc, fr, fq); }
            if constexpr (SP2) {
            PG8_LDB(B0, 0, 0); PG8_LDB(B1, 0, 1); PG8_SCHED; PG8_LDA(At, 0, 0); PG8_STAGE(PG8_SA(1, 1), a1 + hstep, voffA);
            PG8_WAIT_V(8); PG8_WAIT_L(0); PG8_BAR; PG8_MMA(0, 0, At, B0); PG8_MMA(0, 1, At, B1); PG8_BAR; PG8_SCHED;
            PG8_LDA(At, 0, 1); PG8_STAGE(PG8_SB(0, 0), b2, voffB); PG8_STAGE(PG8_SB(0, 1), b2 + hstep, voffB); PG8_STAGE(PG8_SA(0, 0), a2, voffA);
            PG8_WAIT_V(8); PG8_WAIT_L(0); PG8_BAR; PG8_MMA(1, 0, At, B0); PG8_MMA(1, 1, At, B1); PG8_BAR; PG8_SCHED;
            PG8_LDB(B0, 1, 0); PG8_LDB(B1, 1, 1); PG8_SCHED; PG8_LDA(At, 1, 0); PG8_STAGE(PG8_SA(0, 1), a2 + hstep, voffA);
            PG8_WAIT_V(8); PG8_WAIT_L(0); PG8_BAR; PG8_MMA(0, 0, At, B0); PG8_MMA(0, 1, At, B1); PG8_BAR; PG8_SCHED;
            PG8_LDA(At, 1, 1); PG8_STAGE(PG8_SB(1, 0), b3, voffB); PG8_STAGE(PG8_SB(1, 1), b3 + hstep, voffB); PG8_STAGE(PG8_SA(1, 0), a3, voffA);
            PG8_WAIT_V(8); PG8_WAIT_L(0); PG8_BAR; PG8_MMA(1, 0, At, B0); PG8_MMA(1, 1, At, B1); PG8_BAR; PG8_SCHED;
            } else {
            PG8_LDB(B0, 0, 0); PG8_SCHED; PG8_LDA(At, 0, 0); PG8_STAGE(PG8_SA(1, 1), a1 + hstep, voffA);
            PG8_WAIT_L(8); PG8_BAR; PG8_WAIT_L(0); PG8_MMA(0, 0, At, B0); PG8_BAR; PG8_SCHED;
            PG8_LDB(B1, 0, 1); PG8_STAGE(PG8_SB(0, 0), b2, voffB);
            PG8_BAR; PG8_WAIT_L(0); PG8_MMA(0, 1, At, B1); PG8_BAR;
            PG8_LDA(At, 0, 1); PG8_STAGE(PG8_SA(0, 0), a2, voffA);
            PG8_BAR; PG8_WAIT_L(0); PG8_MMA(1, 0, At, B0); PG8_BAR; PG8_SCHED;
            PG8_STAGE(PG8_SB(0, 1), b2 + hstep, voffB);
            PG8_WAIT_V(6); PG8_BAR; PG8_MMA(1, 1, At, B1); PG8_BAR;
            PG8_LDB(B0, 1, 0); PG8_SCHED; PG8_LDA(At, 1, 0); PG8_STAGE(PG8_SA(0, 1), a2 + hstep, voffA);
            PG8_WAIT_L(8); PG8_BAR; PG8_WAIT_L(0); PG8_MMA(0, 0, At, B0); PG8_BAR; PG8_SCHED;
            PG8_LDB(B1, 1, 1); PG8_STAGE(PG8_SB(1, 0), b3, voffB);
            PG8_BAR; PG8_WAIT_L(0); PG8_MMA(0, 1, At, B1); PG8_BAR;
            PG8_LDA(At, 1, 1); PG8_STAGE(PG8_SA(1, 0), a3, voffA);
            PG8_BAR; PG8_WAIT_L(0); PG8_MMA(1, 0, At, B0); PG8_BAR; PG8_SCHED;
            PG8_STAGE(PG8_SB(1, 1), b3 + hstep, voffB);
            PG8_WAIT_V(6); PG8_BAR; PG8_MMA(1, 1, At, B1); PG8_BAR;
            }
        }
        if constexpr (ALIGN_EPI) { if (wr == 0) PG8_BAR; }
        if constexpr (!Epi::AFTER_DRAIN) { E(acc, cur, wr, wc, fr, fq); S.done(cur); }
        if (!has_next) break;
#pragma unroll
        for (int a = 0; a < 2; ++a)
#pragma unroll
            for (int b = 0; b < 2; ++b)
#pragma unroll
                for (int m = 0; m < 4; ++m)
#pragma unroll
                    for (int n = 0; n < 2; ++n) acc[a][b][m][n] = (f32x4){0.f, 0.f, 0.f, 0.f};
        cur = nxt; cA = nA; cB = nB; ++ui;
        if constexpr (ALIGN_EPI) { if (wr == 1) PG8_BAR; }
    }
    PG8_WAIT_V(0);
    if constexpr (!ALIGN_EPI) { if (wr == 0) PG8_BAR; }
    PG8_BAR;
    if constexpr (Epi::AFTER_DRAIN) { E.fused(acc, cur, wr, wc, fr, fq, lds, wid, lane); S.done(cur); }
#undef PG8_SA
#undef PG8_SB
#undef PG8_STAGE
#undef PG8_LDA
#undef PG8_LDB
#undef PG8_MMA
#undef PG8_WAIT_V
#undef PG8_WAIT_L
#undef PG8_BAR
#undef PG8_SCHED
}
}
__device__ __forceinline__ void transpose_item(const float* src, int ld, bf16_t* dst, int K, const float* kscale, float* scr, int lane) {
    float tv[32];
    { int lo = lane; asm volatile("" : "+v"(lo));
      const float* sp = src + (size_t)(lo >> 5) * ld + (lo & 31);
#pragma unroll
      for (int i = 0; i < 32; ++i) tv[i] = sp[(size_t)(2 * i) * ld]; }
    if (kscale) {
#pragma unroll
        for (int i = 0; i < 32; ++i) tv[i] *= kscale[2 * i + (lane >> 5)];
    }
#pragma unroll
    for (int i = 0; i < 32; ++i) { const int kk = 2 * i + (lane >> 5); scr[kk * 33 + (lane & 31)] = tv[i]; }
    LDS_WAIT();
    const int c = lane & 7;
#pragma unroll
    for (int j = 0; j < 4; ++j) { const int n = (lane >> 3) + 8 * j; const float* s = scr + (8 * c) * 33 + n;
        u32x4 o; o.x = cvt_pk_bf16(s[0 * 33], s[1 * 33]); o.y = cvt_pk_bf16(s[2 * 33], s[3 * 33]); o.z = cvt_pk_bf16(s[4 * 33], s[5 * 33]); o.w = cvt_pk_bf16(s[6 * 33], s[7 * 33]);
        *(u32x4*)(dst + (size_t)n * K + 8 * c) = o; }
    LDS_WAIT();
}

__device__ __forceinline__ void phase0(const Params& p, unsigned char* lds) {
    const int tid = threadIdx.x, lane = tid & 63, wave = tid >> 6;
    const int G = gridDim.x, gw = blockIdx.x * 8 + wave, NGW = G * 8, gt = blockIdx.x * 512 + tid, NGT = G * 512;
    unsigned char* ws = p.ws; unsigned char* dob = (unsigned char*)p.out;
    { float* rowsq = (float*)(ws + WS_MISC); for (int i = gt; i < MTOK + 1024; i += NGT) rowsq[i] = 0.f; }
    { float* bias = (float*)(dob + DO_BIAS); const float* rel = p.in[9];
      for (int i = gt; i < 8 * 8192; i += NGT) { const int h = i >> 13, d = i & 8191; int bk;
          if (d < 16) bk = d; else { const float lr = logf(fmaxf((float)d, 16.f) / 16.f) / 4.852030263919617f; bk = 16 + (int)(lr * 16.f); if (bk > 31) bk = 31; }
          bias[i] = rel[bk * 8 + h] * 1.4426950408889634f; } }
    {
        float* scr = (float*)(lds + wave * 8704);
        constexpr int I_IN = 32 * 352, I_B = 16 * 64, I_O = 32 * 64, I_GU = 32 * 352, I_DN = 88 * 64;
        constexpr int NITEMS = I_IN + 2 * I_B + I_O;
        for (int it = gw; it < NITEMS; it += NGW) {
            int r = it;
            if (r < I_IN) { const int kb = r / 352, nb = r % 352, n0 = 32 * nb, sc = n0 + (n0 >= 4096 ? 16 : 0);
                transpose_item(p.in[2] + (size_t)(64 * kb) * WIN_LD + sc, WIN_LD, (bf16_t*)(ws + WS_WIN) + (size_t)n0 * 2048 + 64 * kb, 2048, nullptr, scr, lane); continue; } r -= I_IN;
            if (r < I_B) { const int kb = r / 64, nb = r % 64;
                transpose_item(p.in[10] + (size_t)(64 * kb) * 2048 + 32 * nb, 2048, (bf16_t*)(ws + WS_WBG) + (size_t)(32 * nb) * 2048 + 64 * kb, 2048, nullptr, scr, lane); continue; } r -= I_B;
            if (r < I_B) { const int kb = r / 64, nb = r % 64;
                transpose_item(p.in[11] + (size_t)(64 * kb) * 2048 + 32 * nb, 2048, (bf16_t*)(ws + WS_WBG) + (size_t)(32 * nb) * 2048 + 1024 + 64 * kb, 2048, nullptr, scr, lane); continue; } r -= I_B;
            if (r < I_O) { const int kb = r / 64, nb = r % 64;
                transpose_item(p.in[12] + (size_t)(64 * kb) * 2048 + 32 * nb, 2048, (bf16_t*)(ws + WS_WOUT) + (size_t)(32 * nb) * 2048 + 64 * kb, 2048, nullptr, scr, lane); continue; } r -= I_O;
            if (r < I_GU) { const int kb = r / 352, nb = r % 352, n0 = 32 * nb, pn = n0 >> 8, bj = (n0 >> 7) & 1, j0 = n0 & 127;
                const float* W = bj ? p.in[15] : p.in[14];
                transpose_item(W + (size_t)(64 * kb) * DFF + 128 * pn + j0, DFF, (bf16_t*)(ws + WS_WGU) + (size_t)n0 * 2048 + 64 * kb, 2048, p.in[13] + 64 * kb, scr, lane); continue; } r -= I_GU;
            { const int kb = r / 64, nb = r % 64;
                transpose_item(p.in[16] + (size_t)(64 * kb) * 2048 + 32 * nb, 2048, (bf16_t*)(ws + WS_WDN) + (size_t)(32 * nb) * DFF + 64 * kb, DFF, nullptr, scr, lane); }
        }
    }
    __syncthreads();
    float* Wl = (float*)lds;
    for (int i = tid; i < 2048 * 16; i += 512) { const int k = i >> 4, j = i & 15; Wl[j * 2048 + k] = p.in[2][(size_t)k * WIN_LD + 4096 + j]; }
    __syncthreads();
    {
        bf16_t* un = (bf16_t*)dob;
        float* betab = (float*)(dob + DO_BETA); float* gb = (float*)(dob + DO_G);
        f32x4 nw[8];
#pragma unroll
        for (int j = 0; j < 8; ++j) nw[j] = ((const f32x4*)p.in[1])[lane + 64 * j];
        const int jo = ((lane >> 5) & 1) * 8 + ((lane >> 4) & 1) * 4 + ((lane >> 3) & 1) * 2 + ((lane >> 2) & 1);
        float extra = 0.f, alog = 0.f;
        if (jo >= 8) { alog = expf(p.in[4][jo - 8]); extra = p.in[5][jo - 8]; }
        f32x4 vn[8];
        if (gw < MTOK) { const f32x4* xr = (const f32x4*)(p.in[0] + (size_t)gw * 2048) + lane;
#pragma unroll
            for (int j = 0; j < 8; ++j) vn[j] = xr[64 * j]; }
        for (int m = gw; m < MTOK; m += NGW) {
            f32x4 v[8]; float ss = 0.f;
#pragma unroll
            for (int j = 0; j < 8; ++j) { v[j] = vn[j]; ss += v[j][0] * v[j][0] + v[j][1] * v[j][1] + v[j][2] * v[j][2] + v[j][3] * v[j][3]; }
            if (m + NGW < MTOK) { const f32x4* xr = (const f32x4*)(p.in[0] + (size_t)(m + NGW) * 2048) + lane;
#pragma unroll
                for (int j = 0; j < 8; ++j) vn[j] = xr[64 * j]; }
            const float rstd = rsqrtf(wave_sum(ss) * (1.f / 2048.f) + RMS_EPS);
            u32x2* up = (u32x2*)(un + (size_t)m * 2048) + lane;
#pragma unroll
            for (int j = 0; j < 8; ++j) { v[j] = v[j] * rstd * nw[j]; u32x2 w; w.x = cvt_pk_bf16(v[j][0], v[j][1]); w.y = cvt_pk_bf16(v[j][2], v[j][3]); up[64 * j] = w; }
            float d16[16];
#pragma unroll
            for (int jj = 0; jj < 16; ++jj) { float a = 0.f;
#pragma unroll
                for (int j = 0; j < 8; ++j) { const f32x4 w4 = ((const f32x4*)(Wl + jj * 2048))[lane + 64 * j]; a += v[j][0] * w4[0] + v[j][1] * w4[1] + v[j][2] * w4[2] + v[j][3] * w4[3]; }
                d16[jj] = a; }
            float r8[8], r4[4], r2[2];
            { const bool hi = (lane & 32) != 0;
#pragma unroll
              for (int i = 0; i < 8; ++i) { const float snd = hi ? d16[i] : d16[i + 8], kp = hi ? d16[i + 8] : d16[i]; r8[i] = kp + __shfl_xor(snd, 32); } }
            { const bool hi = (lane & 16) != 0;
#pragma unroll
              for (int i = 0; i < 4; ++i) { const float snd = hi ? r8[i] : r8[i + 4], kp = hi ? r8[i + 4] : r8[i]; r4[i] = kp + __shfl_xor(snd, 16); } }
            { const bool hi = (lane & 8) != 0;
#pragma unroll
              for (int i = 0; i < 2; ++i) { const float snd = hi ? r4[i] : r4[i + 2], kp = hi ? r4[i + 2] : r4[i]; r2[i] = kp + __shfl_xor(snd, 8); } }
            float mine;
            { const bool hi = (lane & 4) != 0; const float snd = hi ? r2[0] : r2[1], kp = hi ? r2[1] : r2[0]; mine = kp + __shfl_xor(snd, 4); }
            mine += __shfl_xor(mine, 2); mine += __shfl_xor(mine, 1);
            const int b = m >> 13, t = m & 8191;
            if ((lane & 3) == 0) {
                if (jo < 8) betab[(size_t)(b * 8 + jo) * NT + t] = 1.f / (1.f + expf(-mine));
                else { const float xx = mine + extra; const float sp = fmaxf(xx, 0.f) + log1pf(expf(-fabsf(xx))); gb[(size_t)(b * 8 + jo - 8) * NT + t] = -alog * sp; }
            }
        }
    }
}
__device__ __forceinline__ void moba_prep_item(const Params& p, unsigned char* lds, int item) {
    const int tid = threadIdx.x, lane = tid & 63, wave = tid >> 6;
    const int n = item & 31, bh = item >> 5, h = bh & 7, b = bh >> 3;
    bf16_t* proj = (bf16_t*)(p.ws + WS_PROJ);
    bf16_t* mq = proj + 4 * SEC; bf16_t* mk = proj + 5 * SEC; const bf16_t* mv = proj + 6 * SEC;
    bf16_t* vl = (bf16_t*)lds;
    float* red = (float*)(lds + 65536);
    const int grp = tid & 15;
    f32x4 qw0 = *(const f32x4*)(p.in[7] + 8 * grp), qw1 = *(const f32x4*)(p.in[7] + 8 * grp + 4);
    f32x4 kw0 = *(const f32x4*)(p.in[8] + 8 * grp), kw1 = *(const f32x4*)(p.in[8] + 8 * grp + 4);
    float ksum[8];
#pragma unroll
    for (int e = 0; e < 8; ++e) ksum[e] = 0.f;
    const float qscale = 0.08838834764831845f * 1.4426950408889634f;
    int tr = tid >> 4; asm volatile("" : "+v"(tr));
#pragma unroll 1
    for (int pb = 0; pb < 2; ++pb) {
    u32x4 qr[4], kr[4], vr[4];
#pragma unroll
    for (int pp = 0; pp < 4; ++pp) { const size_t off = ((size_t)b * NT + n * 256 + 32 * (4 * pb + pp) + tr) * 1024 + h * 128 + 8 * grp;
        qr[pp] = *(const u32x4*)(mq + off); kr[pp] = *(const u32x4*)(mk + off); vr[pp] = *(const u32x4*)(mv + off); }
#pragma unroll
    for (int pp = 0; pp < 4; ++pp) {
        const int ps = 4 * pb + pp;
        const int r = 32 * ps + tr;
        const size_t off = ((size_t)b * NT + n * 256 + r) * 1024 + h * 128 + 8 * grp;
        const u32x4 qv = qr[pp], kv = kr[pp], vv = vr[pp];
        *(u32x4*)(vl + r * 128 + 8 * (grp ^ (((r >> 5) + 2 * ((r >> 2) & 3)) & 7))) = vv;
        float q[8] = {bflo(qv.x), bfhi(qv.x), bflo(qv.y), bfhi(qv.y), bflo(qv.z), bfhi(qv.z), bflo(qv.w), bfhi(qv.w)};
        float k[8] = {bflo(kv.x), bfhi(kv.x), bflo(kv.y), bfhi(kv.y), bflo(kv.z), bfhi(kv.z), bflo(kv.w), bfhi(kv.w)};
        float sq = 0.f, sk = 0.f;
#pragma unroll
        for (int e = 0; e < 8; ++e) { sq += q[e] * q[e]; sk += k[e] * k[e]; }
#pragma unroll
        for (int o = 1; o < 16; o <<= 1) { sq += __shfl_xor(sq, o); sk += __shfl_xor(sk, o); }
        const float rq = rsqrtf(sq * (1.f / 128.f) + RMS_EPS) * qscale, rk = rsqrtf(sk * (1.f / 128.f) + RMS_EPS);
        q[0] *= rq * qw0[0]; q[1] *= rq * qw0[1]; q[2] *= rq * qw0[2]; q[3] *= rq * qw0[3]; q[4] *= rq * qw1[0]; q[5] *= rq * qw1[1]; q[6] *= rq * qw1[2]; q[7] *= rq * qw1[3];
        k[0] *= rk * kw0[0]; k[1] *= rk * kw0[1]; k[2] *= rk * kw0[2]; k[3] *= rk * kw0[3]; k[4] *= rk * kw1[0]; k[5] *= rk * kw1[1]; k[6] *= rk * kw1[2]; k[7] *= rk * kw1[3];
#pragma unroll
        for (int e = 0; e < 8; ++e) ksum[e] += k[e];
        u32x4 qo, ko;
        qo.x = cvt_pk_bf16(q[0], q[1]); qo.y = cvt_pk_bf16(q[2], q[3]); qo.z = cvt_pk_bf16(q[4], q[5]); qo.w = cvt_pk_bf16(q[6], q[7]);
        ko.x = cvt_pk_bf16(k[0], k[1]); ko.y = cvt_pk_bf16(k[2], k[3]); ko.z = cvt_pk_bf16(k[4], k[5]); ko.w = cvt_pk_bf16(k[6], k[7]);
        *(u32x4*)(mq + off) = qo; *(u32x4*)(mk + off) = ko;
    }
    }
#pragma unroll
    for (int e = 0; e < 8; ++e) { ksum[e] += __shfl_xor(ksum[e], 16); ksum[e] += __shfl_xor(ksum[e], 32); }
    if (lane < 16) {
#pragma unroll
        for (int e = 0; e < 8; ++e) red[wave * 128 + 8 * lane + e] = ksum[e];
    }
    __syncthreads();
    if (tid < 128) { float s = 0.f;
#pragma unroll
        for (int w = 0; w < 8; ++w) s += red[w * 128 + tid];
        ((float*)((unsigned char*)p.out + DO_KMEAN))[(size_t)item * 128 + tid] = s * (1.f / 256.f); }
    bf16_t* vT = (bf16_t*)(p.ws + WS_T2) + (size_t)item * 32768;
#pragma unroll 2
    for (int it = 0; it < 8; ++it) {
        const int d = (tid >> 5) + 16 * it, pg = tid & 31, kg = pg >> 2, g4 = pg & 3;
        unsigned short e[8];
#pragma unroll
        for (int j = 0; j < 8; ++j) { const int key = 32 * kg + 16 * (j >> 2) + 4 * g4 + (j & 3); e[j] = vl[key * 128 + 8 * ((d >> 3) ^ (((key >> 5) + 2 * ((key >> 2) & 3)) & 7)) + (d & 7)]; }
        u32x4 o; o.x = e[0] | ((unsigned)e[1] << 16); o.y = e[2] | ((unsigned)e[3] << 16); o.z = e[4] | ((unsigned)e[5] << 16); o.w = e[6] | ((unsigned)e[7] << 16);
        *(u32x4*)(vT + d * 256 + pg * 8) = o;
    }
    __syncthreads();
}

constexpr int RS = 132;
constexpr int GP_QB = 0, GP_KB = 17408, GP_RK = 34816, GP_RV = 68608, GP_KDT = 102400, GP_LM = 120832, GP_AML = 137216, GP_GC = 146432, GP_BETA = 146688, GP_CW = 146944;
static_assert(GP_CW + 6144 <= LDS_BYTES, "gdn prep LDS");
#define LBAR() asm volatile("s_waitcnt lgkmcnt(0)\n\ts_barrier" ::: "memory")
template <int J> __device__ __forceinline__ void macb(float& s, int Lq, float x) { asm volatile("v_fmac_f32_dpp %0, %1, %2 row_newbcast:%3 row_mask:0xf bank_mask:0xf" : "+v"(s) : "v"(Lq), "v"(x), "n"(J)); }
template <int J, int N, int OFF> struct MacDpp { static __device__ __forceinline__ void run(int Lq, const float (&xs)[64], float& s0, float& s1) {
    if constexpr (J < N) { if constexpr (J & 1) macb<J>(s1, Lq, xs[OFF + J]); else macb<J>(s0, Lq, xs[OFF + J]); MacDpp<J + 1, N, OFF>::run(Lq, xs, s0, s1); } } };
template <int I> struct SolveRow { static __device__ __forceinline__ void run(const float* Lneg, const float* base, float (&xs)[64], const int (&Lc)[4], float rc, int lane15) {
    int Ln[4] = {0, 0, 0, 0}; float rn = 0.f;
    if constexpr (I < 63) { constexpr int NQ = (I + 1 + 15) / 16;
        if constexpr (NQ > 0) Ln[0] = __float_as_int(Lneg[(I + 1) * 64 + lane15]);
        if constexpr (NQ > 1) Ln[1] = __float_as_int(Lneg[(I + 1) * 64 + 16 + lane15]);
        if constexpr (NQ > 2) Ln[2] = __float_as_int(Lneg[(I + 1) * 64 + 32 + lane15]);
        if constexpr (NQ > 3) Ln[3] = __float_as_int(Lneg[(I + 1) * 64 + 48 + lane15]);
        rn = base[(I + 1) * RS]; }
    float s0 = rc, s1 = 0.f;
    MacDpp<0, (I > 16 ? 16 : I), 0>::run(Lc[0], xs, s0, s1);
    if constexpr (I > 16) MacDpp<0, (I > 32 ? 16 : I - 16), 16>::run(Lc[1], xs, s0, s1);
    if constexpr (I > 32) MacDpp<0, (I > 48 ? 16 : I - 32), 32>::run(Lc[2], xs, s0, s1);
    if constexpr (I > 48) MacDpp<0, I - 48, 48>::run(Lc[3], xs, s0, s1);
    xs[I] = s0 + s1;
    __builtin_amdgcn_sched_barrier(0);
    if constexpr (I < 63) SolveRow<I + 1>::run(Lneg, base, xs, Ln, rn, lane15);
} };
#define GP_ISSUE(raw_, gpre_, bpre_, item_) do { const int c_ = (item_) & 127, bh_ = (item_) >> 7, h_ = bh_ & 7, b_ = bh_ >> 3, t0_ = c_ * 64; \
    const bf16_t* pj_ = (const bf16_t*)(p.ws + WS_PROJ); const int ch_ = h_ * 128 + 8 * ((int)threadIdx.x & 15); \
    _Pragma("unroll") for (int sec = 0; sec < 3; ++sec) _Pragma("unroll") for (int ps = 0; ps < 2; ++ps) _Pragma("unroll") for (int j = 0; j < 4; ++j) { \
        const int tt = t0_ + 32 * ps + ((int)threadIdx.x >> 4) - 3 + j; raw_[sec][ps][j] = (u32x4){0u, 0u, 0u, 0u}; \
        if (tt >= 0) raw_[sec][ps][j] = *(const u32x4*)(pj_ + (size_t)sec * SEC + ((size_t)b_ * NT + tt) * 1024 + ch_); } \
    if (threadIdx.x < 64) { gpre_ = ((const float*)((const unsigned char*)p.out + DO_G))[(size_t)bh_ * NT + t0_ + threadIdx.x]; \
        bpre_ = ((const float*)((const unsigned char*)p.out + DO_BETA))[(size_t)bh_ * NT + t0_ + threadIdx.x]; } } while (0)
__device__ __forceinline__ void gdn_prep_item(const Params& p, unsigned char* lds, int item, u32x4 (&raw)[3][2][4], float& gpre, float& bpre, int next_item) {
    const int tid = threadIdx.x, lane = tid & 63, wave = tid >> 6;
    const int c = item & 127, bh = item >> 7, h = bh & 7, b = bh >> 3;
    const int t0 = c * 64;
    unsigned char* dob = (unsigned char*)p.out;
    unsigned char* rec = dob + (size_t)item * REC_BYTES;
    const bf16_t* proj = (const bf16_t*)(p.ws + WS_PROJ);
    bf16_t* qb = (bf16_t*)(lds + GP_QB); bf16_t* kb = (bf16_t*)(lds + GP_KB);
    float* rhsK = (float*)(lds + GP_RK); float* rhsV = (float*)(lds + GP_RV);
    bf16_t* kdT = (bf16_t*)(lds + GP_KDT); float* Lm = (float*)(lds + GP_LM); bf16_t* Aml = (bf16_t*)(lds + GP_AML);
    float* gcs = (float*)(lds + GP_GC); float* bets = (float*)(lds + GP_BETA);
    const int grp = tid & 15, a16 = grp >> 1, bb = grp & 1;
    if (wave == 0) {
        float g = gpre; const float be = bpre;
#pragma unroll
        for (int o = 1; o < 64; o <<= 1) { const float t = __shfl_up(g, o); if (lane >= o) g += t; }
        gcs[lane] = g; bets[lane] = be;
        if (lane == 63) ((float*)(dob + DO_GL))[item] = __expf(g);
    }
    LBAR();
    const float glast = gcs[63];
    {
        const float* cwl = (const float*)(lds + GP_CW);
#pragma unroll
        for (int sec = 0; sec < 3; ++sec) {
#pragma unroll
            for (int ps = 0; ps < 2; ++ps) {
                const int i = 32 * ps + (tid >> 4);
                float y[8];
#pragma unroll
                for (int e = 0; e < 8; ++e) y[e] = 0.f;
#pragma unroll
                for (int j = 0; j < 4; ++j) { const u32x4 w = raw[sec][ps][j];
                    const f32x4 c0 = *(const f32x4*)(cwl + (j * 3 + sec) * 128 + 8 * grp), c1 = *(const f32x4*)(cwl + (j * 3 + sec) * 128 + 8 * grp + 4);
                    y[0] += c0[0] * bflo(w.x); y[1] += c0[1] * bfhi(w.x); y[2] += c0[2] * bflo(w.y); y[3] += c0[3] * bfhi(w.y);
                    y[4] += c1[0] * bflo(w.z); y[5] += c1[1] * bfhi(w.z); y[6] += c1[2] * bflo(w.w); y[7] += c1[3] * bfhi(w.w); }
#pragma unroll
                for (int e = 0; e < 8; ++e) y[e] = y[e] * __builtin_amdgcn_rcpf(1.f + __expf(-y[e]));
                const float gci = gcs[i], bi = bets[i];
                if (sec < 2) {
                    float ss = 0.f;
#pragma unroll
                    for (int e = 0; e < 8; ++e) ss += y[e] * y[e];
#pragma unroll
                    for (int o = 1; o < 16; o <<= 1) ss += __shfl_xor(ss, o);
                    const float rn = rsqrtf(ss + RMS_EPS);
                    if (sec == 0) {
                        const float sc = rn * 0.08838834764831845f, eg = __expf(gci);
#pragma unroll
                        for (int e = 0; e < 8; ++e) y[e] *= sc;
                        u32x4 w; w.x = cvt_pk_bf16(y[0], y[1]); w.y = cvt_pk_bf16(y[2], y[3]); w.z = cvt_pk_bf16(y[4], y[5]); w.w = cvt_pk_bf16(y[6], y[7]);
                        *(u32x4*)(qb + i * 136 + 8 * grp) = w;
                        u32x2 lo, hi; lo.x = cvt_pk_bf16(y[0] * eg, y[1] * eg); lo.y = cvt_pk_bf16(y[2] * eg, y[3] * eg); hi.x = cvt_pk_bf16(y[4] * eg, y[5] * eg); hi.y = cvt_pk_bf16(y[6] * eg, y[7] * eg);
                        bf16_t* qd = (bf16_t*)(rec + 16384) + i * 128 + 16 * a16;
                        *(u32x2*)(qd + 4 * bb) = lo; *(u32x2*)(qd + 8 + 4 * bb) = hi;
                    } else {
#pragma unroll
                        for (int e = 0; e < 8; ++e) y[e] *= rn;
                        u32x4 w; w.x = cvt_pk_bf16(y[0], y[1]); w.y = cvt_pk_bf16(y[2], y[3]); w.z = cvt_pk_bf16(y[4], y[5]); w.w = cvt_pk_bf16(y[6], y[7]);
                        *(u32x4*)(kb + i * 136 + 8 * grp) = w;
                        const float f1 = bi * __expf(gci), f2 = __expf(glast - gci);
                        f32x4 r0 = {y[0] * f1, y[1] * f1, y[2] * f1, y[3] * f1}, r1 = {y[4] * f1, y[5] * f1, y[6] * f1, y[7] * f1};
                        *(f32x4*)(rhsK + i * RS + 8 * grp) = r0; *(f32x4*)(rhsK + i * RS + 8 * grp + 4) = r1;
                        const int pos = (i & ~15) + perm16(i & 15);
#pragma unroll
                        for (int e = 0; e < 8; ++e) kdT[(8 * grp + e) * 72 + (pos ^ ((grp & 7) << 3))] = (bf16_t)f2bf(y[e] * f2);
                    }
                } else {
                    f32x4 r0 = {y[0] * bi, y[1] * bi, y[2] * bi, y[3] * bi}, r1 = {y[4] * bi, y[5] * bi, y[6] * bi, y[7] * bi};
                    *(f32x4*)(rhsV + i * RS + 8 * grp) = r0; *(f32x4*)(rhsV + i * RS + 8 * grp + 4) = r1;
                }
            }
        }
    }
    LBAR();
    {
        const int mat = wave >> 2, ti = (wave >> 1) & 1, tj = wave & 1, r32 = lane & 31, g = lane >> 5;
        f32x16 acc;
#pragma unroll
        for (int r = 0; r < 16; ++r) acc[r] = 0.f;
        if (tj <= ti && !(p.flags & 32)) {
            const bf16_t* Xa = (mat ? qb : kb) + (32 * ti + r32) * 136 + 8 * g;
            const bf16_t* Xb = kb + (32 * tj + r32) * 136 + 8 * g;
#pragma unroll
            for (int s = 0; s < 8; ++s) { const bf16x8 a = *(const bf16x8*)(Xa + 16 * s), bq = *(const bf16x8*)(Xb + 16 * s); acc = __builtin_amdgcn_mfma_f32_32x32x16_bf16(a, bq, acc, 0, 0, 0); }
        }
        const int j = 32 * tj + r32; const float gcj = gcs[j];
        const int posj = (j & ~15) + perm16(j & 15);
        int ib = 32 * ti + 4 * g; asm volatile("" : "+v"(ib));
        const float* gci_p = gcs + ib; const float* bti_p = bets + ib;
#pragma unroll
        for (int r = 0; r < 16; ++r) { const int io = (r & 3) + 8 * (r >> 2); const int i = ib + io;
            const float gi = gci_p[io], bt = bti_p[io];
            const float dec = __expf(fminf(gi - gcj, 0.f));
            const float lv = (i > j) ? acc[r] * bt * dec : 0.f, av = (i >= j) ? acc[r] * dec : 0.f;
            if (mat == 0) Lm[i * 64 + j] = -lv;
            else Aml[i * 72 + posj] = (bf16_t)f2bf(av); }
    }
    LBAR();
    if (next_item >= 0) GP_ISSUE(raw, gpre, bpre, next_item);
    if (tid < 256 && !(p.flags & 16)) {
        float* base = (tid < 128) ? (rhsK + tid) : (rhsV + (tid - 128));
        float xs[64];
#pragma unroll
        for (int i = 0; i < 64; ++i) xs[i] = 0.f;
        { const int L0[4] = {0, 0, 0, 0}; SolveRow<0>::run(Lm, base, xs, L0, base[0], lane & 15); }
#pragma unroll
        for (int i = 0; i < 64; ++i) base[i * RS] = xs[i];
    } else if (tid >= 256) {
        const int t2 = tid - 256;
#pragma unroll
        for (int k = 0; k < 4; ++k) { const int pc = t2 + 256 * k, row = pc >> 3, cc = pc & 7;
            *(u32x4*)(rec + 32768 + row * 128 + cc * 16) = *(const u32x4*)((const unsigned char*)kdT + row * 144 + ((cc ^ ((row >> 3) & 7)) * 16)); }
#pragma unroll
        for (int k = 0; k < 2; ++k) { const int pc = t2 + 256 * k, row = pc >> 3, cc = pc & 7;
            *(u32x4*)(rec + 49152 + row * 128 + cc * 16) = *(const u32x4*)((const unsigned char*)Aml + row * 144 + cc * 16); }
    }
    LBAR();
    {
        const int i = tid >> 3, a = tid & 7;
        float v[16];
#pragma unroll
        for (int q4 = 0; q4 < 4; ++q4) { const f32x4 t = *(const f32x4*)(rhsK + i * RS + 16 * a + 4 * q4); v[4 * q4] = -t[0]; v[4 * q4 + 1] = -t[1]; v[4 * q4 + 2] = -t[2]; v[4 * q4 + 3] = -t[3]; }
        u32x4 o0, o1;
        o0.x = cvt_pk_bf16(v[0], v[1]); o0.y = cvt_pk_bf16(v[2], v[3]); o0.z = cvt_pk_bf16(v[8], v[9]); o0.w = cvt_pk_bf16(v[10], v[11]);
        o1.x = cvt_pk_bf16(v[4], v[5]); o1.y = cvt_pk_bf16(v[6], v[7]); o1.z = cvt_pk_bf16(v[12], v[13]); o1.w = cvt_pk_bf16(v[14], v[15]);
        *(u32x4*)(rec + i * 256 + a * 32) = o0; *(u32x4*)(rec + i * 256 + a * 32 + 16) = o1;
    }
    {
        const int sl = tid >> 7, mt = (tid >> 6) & 1, g = lane >> 5, cn = lane & 31;
        float v[16];
#pragma unroll
        for (int r = 0; r < 16; ++r) v[r] = rhsV[(32 * mt + (r & 3) + 8 * (r >> 2) + 4 * g) * RS + 32 * sl + cn];
        u32x4 o0, o1;
        o0.x = cvt_pk_bf16(v[0], v[1]); o0.y = cvt_pk_bf16(v[2], v[3]); o0.z = cvt_pk_bf16(v[4], v[5]); o0.w = cvt_pk_bf16(v[6], v[7]);
        o1.x = cvt_pk_bf16(v[8], v[9]); o1.y = cvt_pk_bf16(v[10], v[11]); o1.z = cvt_pk_bf16(v[12], v[13]); o1.w = cvt_pk_bf16(v[14], v[15]);
        unsigned char* ub = p.ws + WS_T0 + (size_t)item * 16384 + (size_t)(((sl * 2 + mt) * 64 + lane) * 32);
        *(u32x4*)ub = o0; *(u32x4*)(ub + 16) = o1;
    }
    LBAR();
}
__device__ __forceinline__ void route_item(const Params& p, float* sc  , int witem, int lane) {
    const int qt = witem & 255, bh = witem >> 8, h = bh & 7, b = bh >> 3, qblk = qt >> 3;
    unsigned* sel = (unsigned*)((unsigned char*)p.out + DO_SEL) + (size_t)bh * NT + 32 * qt;
    if (qblk == 0) { if (lane < 32) sel[lane] = 0xFFFFFFu; return; }
    const int r32 = lane & 31, g = lane >> 5;
    const bf16_t* qrow = (const bf16_t*)(p.ws + WS_PROJ) + 4 * SEC + ((size_t)b * NT + 32 * qt + r32) * 1024 + h * 128 + 8 * g;
    const float* km = (const float*)((unsigned char*)p.out + DO_KMEAN) + ((size_t)bh * 32 + r32) * 128 + 8 * g;
    f32x16 acc;
#pragma unroll
    for (int r = 0; r < 16; ++r) acc[r] = 0.f;
#pragma unroll
    for (int s = 0; s < 8; ++s) {
        const bf16x8 a = *(const bf16x8*)(qrow + 16 * s);
        const f32x4 k0 = *(const f32x4*)(km + 16 * s), k1 = *(const f32x4*)(km + 16 * s + 4);
        float kf[8] = {k0[0], k0[1], k0[2], k0[3], k1[0], k1[1], k1[2], k1[3]};
        unsigned hi[8], lo[8];
#pragma unroll
        for (int e = 0; e < 8; ++e) { hi[e] = f2bf(kf[e]); lo[e] = f2bf(kf[e] - __uint_as_float(hi[e] << 16)); }
        u32x4 hw, lw;
        hw.x = hi[0] | (hi[1] << 16); hw.y = hi[2] | (hi[3] << 16); hw.z = hi[4] | (hi[5] << 16); hw.w = hi[6] | (hi[7] << 16);
        lw.x = lo[0] | (lo[1] << 16); lw.y = lo[2] | (lo[3] << 16); lw.z = lo[4] | (lo[5] << 16); lw.w = lo[6] | (lo[7] << 16);
        acc = __builtin_amdgcn_mfma_f32_32x32x16_bf16(a, __builtin_bit_cast(bf16x8, hw), acc, 0, 0, 0);
        acc = __builtin_amdgcn_mfma_f32_32x32x16_bf16(a, __builtin_bit_cast(bf16x8, lw), acc, 0, 0, 0);
    }
#pragma unroll
    for (int r = 0; r < 16; ++r) sc[((r & 3) + 8 * (r >> 2) + 4 * g) * 33 + r32] = acc[r];
    LDS_WAIT();
    if (lane < 32) {
        float b0 = -3e38f, b1 = -3e38f, b2 = -3e38f; unsigned i0 = 255, i1 = 255, i2 = 255;
        for (int n = 0; n < qblk; ++n) { const float v = sc[lane * 33 + n];
            if (v > b0) { b2 = b1; i2 = i1; b1 = b0; i1 = i0; b0 = v; i0 = n; }
            else if (v > b1) { b2 = b1; i2 = i1; b1 = v; i1 = n; }
            else if (v > b2) { b2 = v; i2 = n; } }
        sel[lane] = i0 | (i1 << 8) | (i2 << 16);
    }
    LDS_WAIT();
}

constexpr int SC_W = 0, SC_Q = 17408, SC_K = 34816, SC_A = 53248, SC_BUF = 62464;
__device__ __forceinline__ void scan_bh(const Params& p, unsigned char* lds, int bh) {
    const int tid = threadIdx.x, lane = tid & 63, wave = tid >> 6;
    const int h = bh & 7, b = bh >> 3, r32 = lane & 31, g = lane >> 5;
    unsigned char* dob = (unsigned char*)p.out;
    const unsigned char* recb = dob + (size_t)bh * 128 * REC_BYTES;
    const unsigned char* ub = p.ws + WS_T0 + (size_t)bh * 128 * 16384;
    const float* glp = (const float*)(dob + DO_GL) + bh * 128;
    bf16_t* ob = (bf16_t*)(p.ws + WS_T1);
    const bool loader = wave >= 4;
    const int lt = tid - 256;
    u32x4 st[14];
#define SC_ISSUE(c_) do { const unsigned char* rp = recb + (size_t)(c_) * REC_BYTES + lt * 16; \
        _Pragma("unroll") for (int k = 0; k < 14; ++k) st[k] = *(const u32x4*)(rp + 4096 * k); } while (0)
#define SC_COMMIT(buf_) do { unsigned char* Lw = lds + (buf_) * SC_BUF; \
        _Pragma("unroll") for (int k = 0; k < 14; ++k) { const int off = lt * 16 + 4096 * k; int dst; \
            if (k < 4) { const int o = off; dst = SC_W + (o >> 8) * 272 + (o & 255); } \
            else if (k < 8) { const int o = off - 16384; dst = SC_Q + (o >> 8) * 272 + (o & 255); } \
            else if (k < 12) { const int o = off - 32768; dst = SC_K + (o >> 7) * 144 + (o & 127); } \
            else { const int o = off - 49152; dst = SC_A + (o >> 7) * 144 + (o & 127); } \
            *(u32x4*)(Lw + dst) = st[k]; } } while (0)
    f32x16 S[4];
#pragma unroll
    for (int kt = 0; kt < 4; ++kt)
#pragma unroll
        for (int r = 0; r < 16; ++r) S[kt][r] = 0.f;
    u32x4 un[4];
    float gln = 1.f;
    const int sl = wave;
    if (loader) { SC_ISSUE(0); SC_COMMIT(0); SC_ISSUE(1); }
    else {
        const unsigned char* up = ub + (size_t)((sl * 2) * 64 + lane) * 32;
        un[0] = *(const u32x4*)up; un[1] = *(const u32x4*)(up + 16); un[2] = *(const u32x4*)(up + 2048); un[3] = *(const u32x4*)(up + 2048 + 16);
        gln = glp[0];
    }
    __syncthreads();
    for (int c = 0; c < 128; ++c) {
        if (loader) {
            if (c + 1 < 128) SC_COMMIT((c + 1) & 1);
            if (c + 2 < 128) SC_ISSUE(c + 2);
        } else {
            const unsigned char* L = lds + (c & 1) * SC_BUF;
            u32x4 uc[4] = {un[0], un[1], un[2], un[3]}; const float gl = gln;
            if (c + 1 < 128) { const unsigned char* up = ub + (size_t)(c + 1) * 16384 + (size_t)((sl * 2) * 64 + lane) * 32;
                un[0] = *(const u32x4*)up; un[1] = *(const u32x4*)(up + 16); un[2] = *(const u32x4*)(up + 2048); un[3] = *(const u32x4*)(up + 2048 + 16);
                gln = glp[c + 1]; }
            bf16x8 Sb[8];
#pragma unroll
            for (int s = 0; s < 8; ++s) { const int kt = s >> 1, o = 8 * (s & 1); u32x4 w;
                w.x = cvt_pk_bf16(S[kt][o], S[kt][o + 1]); w.y = cvt_pk_bf16(S[kt][o + 2], S[kt][o + 3]); w.z = cvt_pk_bf16(S[kt][o + 4], S[kt][o + 5]); w.w = cvt_pk_bf16(S[kt][o + 6], S[kt][o + 7]);
                Sb[s] = __builtin_bit_cast(bf16x8, w); }
            f32x16 vn[2];
#pragma unroll
            for (int mt = 0; mt < 2; ++mt) {
#pragma unroll
                for (int r = 0; r < 16; ++r) vn[mt][r] = 0.f;
                const unsigned char* wa = L + SC_W + (32 * mt + r32) * 272 + 16 * g;
#pragma unroll
                for (int s = 0; s < 8; ++s) { const bf16x8 a = *(const bf16x8*)(wa + 32 * s); vn[mt] = __builtin_amdgcn_mfma_f32_32x32x16_bf16(a, Sb[s], vn[mt], 0, 0, 0); }
                const u32x4 u0 = uc[2 * mt], u1 = uc[2 * mt + 1];
                vn[mt][0] += bflo(u0.x); vn[mt][1] += bfhi(u0.x); vn[mt][2] += bflo(u0.y); vn[mt][3] += bfhi(u0.y); vn[mt][4] += bflo(u0.z); vn[mt][5] += bfhi(u0.z); vn[mt][6] += bflo(u0.w); vn[mt][7] += bfhi(u0.w);
                vn[mt][8] += bflo(u1.x); vn[mt][9] += bfhi(u1.x); vn[mt][10] += bflo(u1.y); vn[mt][11] += bfhi(u1.y); vn[mt][12] += bflo(u1.z); vn[mt][13] += bfhi(u1.z); vn[mt][14] += bflo(u1.w); vn[mt][15] += bfhi(u1.w);
            }
            bf16x8 Vb[4];
#pragma unroll
            for (int s = 0; s < 4; ++s) { const int mt = s >> 1, oo = 8 * (s & 1); u32x4 w;
                w.x = cvt_pk_bf16(vn[mt][oo], vn[mt][oo + 1]); w.y = cvt_pk_bf16(vn[mt][oo + 2], vn[mt][oo + 3]); w.z = cvt_pk_bf16(vn[mt][oo + 4], vn[mt][oo + 5]); w.w = cvt_pk_bf16(vn[mt][oo + 6], vn[mt][oo + 7]);
                Vb[s] = __builtin_bit_cast(bf16x8, w); }
#pragma unroll
            for (int mt = 0; mt < 2; ++mt) {
                f32x16 o;
#pragma unroll
                for (int r = 0; r < 16; ++r) o[r] = 0.f;
                const unsigned char* qa = L + SC_Q + (32 * mt + r32) * 272 + 16 * g;
#pragma unroll
                for (int s = 0; s < 8; ++s) { const bf16x8 a = *(const bf16x8*)(qa + 32 * s); o = __builtin_amdgcn_mfma_f32_32x32x16_bf16(a, Sb[s], o, 0, 0, 0); }
                const unsigned char* aa = L + SC_A + (32 * mt + r32) * 144 + 16 * g;
#pragma unroll
                for (int s = 0; s < 4; ++s) if (s <= 2 * mt + 1) { const bf16x8 a = *(const bf16x8*)(aa + 32 * s); o = __builtin_amdgcn_mfma_f32_32x32x16_bf16(a, Vb[s], o, 0, 0, 0); }
#pragma unroll
                for (int r = 0; r < 16; ++r) { const int tok = 64 * c + 32 * mt + (r & 3) + 8 * (r >> 2) + 4 * g;
                    ob[((size_t)b * NT + tok) * 1024 + h * 128 + 32 * sl + r32] = (bf16_t)f2bf(o[r]); }
                __builtin_amdgcn_sched_barrier(0);
            }
#pragma unroll
            for (int kt = 0; kt < 4; ++kt) {
#pragma unroll
                for (int r = 0; r < 16; ++r) S[kt][r] *= gl;
                const unsigned char* ka = L + SC_K + (32 * kt + r32) * 144 + 16 * g;
#pragma unroll
                for (int s = 0; s < 4; ++s) { const bf16x8 a = *(const bf16x8*)(ka + 32 * s); S[kt] = __builtin_amdgcn_mfma_f32_32x32x16_bf16(a, Vb[s], S[kt], 0, 0, 0); }
            }
        }
        __syncthreads();
    }
}
constexpr int AT_K = 0, AT_V = 69632, AT_Q = 137216, AT_B = 141312, AT_MISC = 149504;
static_assert(AT_MISC + 64 <= LDS_BYTES, "attn LDS");
__device__ __forceinline__ void attn_item(const Params& p, unsigned char* lds, int item) {
    const int tid = threadIdx.x, lane = tid & 63, wave = tid >> 6;
    const int n = item >> 5, bh = item & 31, h = bh & 7, b = bh >> 3;
    unsigned char* dob = (unsigned char*)p.out;
    const bf16_t* proj = (const bf16_t*)(p.ws + WS_PROJ);
    const bf16_t* mq = proj + 4 * SEC; const bf16_t* mk = proj + 5 * SEC;
    {
        const unsigned char* ksrc = (const unsigned char*)(mk + ((size_t)b * NT + n * 256) * 1024 + h * 128);
        const unsigned char* vsrc = p.ws + WS_T2 + (size_t)((bh * 32) + n) * 65536;
        int tido = tid; asm volatile("" : "+v"(tido));
#pragma unroll
        for (int k = 0; k < 8; ++k) { const int pc = tido + 512 * k, row = pc >> 4, cc = pc & 15;
            *(u32x4*)(lds + AT_K + row * 272 + cc * 16) = *(const u32x4*)(ksrc + (size_t)row * 2048 + cc * 16); }
#pragma unroll
        for (int k = 0; k < 8; ++k) { const int pc = tido + 512 * k, row = pc >> 5, cc = pc & 31;
            *(u32x4*)(lds + AT_V + row * 528 + cc * 16) = *(const u32x4*)(vsrc + (size_t)pc * 16); }
        *(u32x4*)(lds + AT_B + tido * 16) = *(const u32x4*)((const unsigned char*)dob + DO_BIAS + (size_t)h * 32768 + tido * 16);
    }
    __syncthreads();
    volatile unsigned* queue = (volatile unsigned*)(lds + AT_Q) + wave * 128;
    const unsigned* sel = (const unsigned*)(dob + DO_SEL) + (size_t)bh * NT;
    float* ML = (float*)(dob + DO_ML);
    bf16_t* projw = (bf16_t*)(p.ws + WS_PROJ);
    const int qi = lane & 15, g4 = lane >> 4;
    const int nchunks = (NT - (n + 1) * 256) / 64;
    const float* biasL = (const float*)(lds + AT_B);
    int own_left = 1, cc = wave, count = 0;
    unsigned svb0, svb1, svb2, svb3; int svn, ccl = wave;
#define AT_REFILL() do { const unsigned so = (unsigned)((n + 1) * 256 + lane + 64 * ccl);        \
        svb0 = (ccl < nchunks) ? sel[so] : 0xFFFFFFFFu; svb1 = (ccl + 8 < nchunks) ? sel[so + 512u] : 0xFFFFFFFFu; \
        svb2 = (ccl + 16 < nchunks) ? sel[so + 1024u] : 0xFFFFFFFFu; svb3 = (ccl + 24 < nchunks) ? sel[so + 1536u] : 0xFFFFFFFFu; ccl += 32; svn = 4; } while (0)
    AT_REFILL();
#define AT_NEXT(have_, tqA_, slA_, vA_, tqB_, slB_, vB_, nkt_) do { have_ = true; tqA_ = 0; tqB_ = 0; slA_ = 3; slB_ = 3; nkt_ = 16; vA_ = false; vB_ = false; \
        if (own_left > 0) { own_left = 0; tqA_ = n * 256 + 32 * wave + qi; tqB_ = tqA_ + 16; vA_ = true; vB_ = true; nkt_ = 2 * wave + 2; } \
        else { \
            while (count < 32 && cc < nchunks) { \
                if (svn == 0) AT_REFILL(); \
                const int t = (n + 1) * 256 + 64 * cc + lane; cc += 8; \
                const unsigned sv = svb0; svb0 = svb1; svb1 = svb2; svb2 = svb3; --svn; const int nv = min(3, t >> 8); int sl = -1; \
                if ((int)(sv & 255u) == n && nv > 0) sl = 0; else if ((int)((sv >> 8) & 255u) == n && nv > 1) sl = 1; else if ((int)((sv >> 16) & 255u) == n && nv > 2) sl = 2; \
                const unsigned long long mask = __ballot(sl >= 0); \
                if (sl >= 0) { const int rank = __popcll(mask & ((1ull << lane) - 1ull)); queue[count + rank] = (unsigned)t | ((unsigned)sl << 16); } \
                count += __popcll(mask); } \
            if (count == 0) have_ = false; \
            else { LDS_WAIT(); const int take = count < 32 ? count : 32; \
                const unsigned eA = queue[qi], eB = queue[16 + qi]; vA_ = qi < take; vB_ = 16 + qi < take; \
                tqA_ = (int)(eA & 0xffffu); slA_ = (int)(eA >> 16); tqB_ = (int)(eB & 0xffffu); slB_ = (int)(eB >> 16); \
                if (!vA_) { tqA_ = 0; slA_ = 0; } if (!vB_) { tqB_ = 0; slB_ = 0; } \
                const unsigned mv = (lane + 32 < count) ? queue[lane + 32] : 0u; \
                LDS_WAIT(); \
                if (lane + 32 < count) queue[lane] = mv; \
                LDS_WAIT(); \
                count -= take; } \
            if (svn == 0 && cc < nchunks) AT_REFILL(); } } while (0)
#define AT_LOADQ(bq_, tq_, valid_) do { const bf16_t* qp = mq + ((size_t)b * NT + tq_) * 1024 + h * 128 + 8 * g4; \
        _Pragma("unroll") for (int s = 0; s < 4; ++s) { u32x4 w = {0u, 0u, 0u, 0u}; if (valid_) w = *(const u32x4*)(qp + 32 * s); bq_[s] = __builtin_bit_cast(bf16x8, w); } } while (0)
#define AT_SOFT(sv_, tq_, valid_, mode_, m_, l_, ot_, pb_) do { \
        float cm = -1e30f; \
        if (mode_ == 2) { _Pragma("unroll") for (int k4 = 0; k4 < 2; ++k4) cm = fmaxf(fmaxf(cm, fmaxf(sv_[k4][0], sv_[k4][1])), fmaxf(sv_[k4][2], sv_[k4][3])); } \
        else if (mode_ == 1) { int d0 = tq_ - n * 256 - 4 * g4 - 32 * ch; asm volatile("" : "+v"(d0));        \
            _Pragma("unroll") for (int k4 = 0; k4 < 2; ++k4) _Pragma("unroll") for (int e = 0; e < 4; ++e) { const unsigned dist = (unsigned)(d0 - (16 * k4 + e)); \
                const float sx = sv_[k4][e] + biasL[min(dist, 2047u)]; sv_[k4][e] = sx; cm = fmaxf(cm, sx); } } \
        else { int d0 = tq_ - n * 256 - 4 * g4 - 32 * ch; asm volatile("" : "+v"(d0)); \
            _Pragma("unroll") for (int k4 = 0; k4 < 2; ++k4) _Pragma("unroll") for (int e = 0; e < 4; ++e) { const int dist = d0 - (16 * k4 + e); \
                const bool ok = valid_ && dist >= 0 && (2 * ch + k4 < nkt); \
                float sx = sv_[k4][e] + biasL[ok ? min(dist, 2047) : 0]; sx = ok ? sx : -1e30f; sv_[k4][e] = sx; cm = fmaxf(cm, sx); } } \
        cm = fmaxf(cm, __shfl_xor(cm, 16)); cm = fmaxf(cm, __shfl_xor(cm, 32)); \
        const float mn = fmaxf(m_, cm); \
        if (__any(mn != m_)) { const float al = __builtin_amdgcn_exp2f(m_ - mn); l_ *= al;        \
            _Pragma("unroll") for (int dt = 0; dt < 8; ++dt) ot_[dt] = ot_[dt] * al; } \
        m_ = mn; \
        _Pragma("unroll") for (int k4 = 0; k4 < 2; ++k4) _Pragma("unroll") for (int e = 0; e < 4; ++e) { const float pe = __builtin_amdgcn_exp2f(sv_[k4][e] - mn); sv_[k4][e] = pe; l_ += pe; } \
        { u32x4 w; w.x = cvt_pk_bf16(sv_[0][0], sv_[0][1]); w.y = cvt_pk_bf16(sv_[0][2], sv_[0][3]); \
            w.z = cvt_pk_bf16(sv_[1][0], sv_[1][1]); w.w = cvt_pk_bf16(sv_[1][2], sv_[1][3]); pb_ = __builtin_bit_cast(bf16x8, w); } } while (0)
#define AT_STORE(ot_, m_, l_, tq_, slot_, valid_, cb_) do { float lt = l_; lt += __shfl_xor(lt, 16); lt += __shfl_xor(lt, 32); \
        if (valid_) { const float inv = 1.f / lt; const int osec = (slot_ == 3) ? 6 : slot_; \
            bf16_t* op = projw + (size_t)osec * SEC + ((size_t)b * NT + tq_) * 1024 + h * 128 + 4 * g4; \
            _Pragma("unroll") for (int dt = 0; dt < 8; ++dt) { u32x2 w; w.x = cvt_pk_bf16(ot_[dt][0] * inv, ot_[dt][1] * inv); w.y = cvt_pk_bf16(ot_[dt][2] * inv, ot_[dt][3] * inv); *(u32x2*)(op + 16 * dt) = w; } \
            if (g4 == 0) { float* mlp = ML + ((size_t)slot_ * 32 * NT + (size_t)bh * NT + tq_) * 2; mlp[0] = m_ + cb_; mlp[1] = lt; } } } while (0)
    own_left = 1;
    bool have, ownP = true; int tqA, tqB, slA, slB, nkt; bool vA, vB; bf16x8 bqA[4], bqB[4];
    AT_NEXT(have, tqA, slA, vA, tqB, slB, vB, nkt);
    if (have) { AT_LOADQ(bqA, tqA, vA); AT_LOADQ(bqB, tqB, vB); }
    while (have) {
        bool haveN; int tqAn, tqBn, slAn, slBn, nktN; bool vAn, vBn; bf16x8 bqAn[4], bqBn[4];
        AT_NEXT(haveN, tqAn, slAn, vAn, tqBn, slBn, vBn, nktN);
        if (haveN) { AT_LOADQ(bqAn, tqAn, vAn); AT_LOADQ(bqBn, tqBn, vBn); }
        const bool farA = __all(!vA || (tqA - (n * 256 + 255) >= 1513)), farB = __all(!vB || (tqB - (n * 256 + 255) >= 1513));
        const int modeA = ownP ? 0 : (farA ? 2 : 1), modeB = ownP ? 0 : (farB ? 2 : 1);
        const float cbA = modeA == 2 ? biasL[2047] : 0.f, cbB = modeB == 2 ? biasL[2047] : 0.f;
        float mA = -1e30f, mB = -1e30f, lA = 0.f, lB = 0.f;
        f32x4 otA[8], otB[8];
#pragma unroll
        for (int dt = 0; dt < 8; ++dt) { otA[dt] = (f32x4){0.f, 0.f, 0.f, 0.f}; otB[dt] = (f32x4){0.f, 0.f, 0.f, 0.f}; }
#pragma unroll
        for (int ch = 0; ch < 8; ++ch) if (2 * ch < nkt) {
            f32x4 sA[2], sB[2];
#pragma unroll
            for (int k4 = 0; k4 < 2; ++k4) { sA[k4] = (f32x4){0.f, 0.f, 0.f, 0.f}; sB[k4] = (f32x4){0.f, 0.f, 0.f, 0.f};
                if (2 * ch + k4 < nkt) { const unsigned char* ka = lds + AT_K + (16 * (2 * ch + k4) + qi) * 272 + 16 * g4;
#pragma unroll
                    for (int s = 0; s < 4; ++s) { const bf16x8 a = *(const bf16x8*)(ka + 64 * s);
                        sA[k4] = __builtin_amdgcn_mfma_f32_16x16x32_bf16(a, bqA[s], sA[k4], 0, 0, 0); sB[k4] = __builtin_amdgcn_mfma_f32_16x16x32_bf16(a, bqB[s], sB[k4], 0, 0, 0); } } }
            bf16x8 pbA, pbB;
            AT_SOFT(sA, tqA, vA, modeA, mA, lA, otA, pbA);
            AT_SOFT(sB, tqB, vB, modeB, mB, lB, otB, pbB);
            { const unsigned char* va = lds + AT_V + qi * 528 + 64 * ch + 16 * g4;
#pragma unroll
              for (int dt = 0; dt < 8; ++dt) { const bf16x8 a = *(const bf16x8*)(va + dt * 16 * 528);
                  otA[dt] = __builtin_amdgcn_mfma_f32_16x16x32_bf16(a, pbA, otA[dt], 0, 0, 0); otB[dt] = __builtin_amdgcn_mfma_f32_16x16x32_bf16(a, pbB, otB[dt], 0, 0, 0); } }
            __builtin_amdgcn_sched_barrier(0);
        }
        AT_STORE(otA, mA, lA, tqA, slA, vA, cbA);
        AT_STORE(otB, mB, lB, tqB, slB, vB, cbB);
        ownP = false; have = haveN; tqA = tqAn; tqB = tqBn; slA = slAn; slB = slBn; vA = vAn; vB = vBn; nkt = nktN;
#pragma unroll
        for (int s = 0; s < 4; ++s) { bqA[s] = bqAn[s]; bqB[s] = bqBn[s]; }
    }
#undef AT_SOFT
#undef AT_STORE
#undef AT_NEXT
#undef AT_REFILL
#undef AT_LOADQ
    __syncthreads();
}

__device__ __forceinline__ void combine_rows(const Params& p, int m0, int mstep, int lane) {
    bf16_t* proj = (bf16_t*)(p.ws + WS_PROJ);
    const float* ML = (const float*)((const unsigned char*)p.out + DO_ML);
    const int h = lane >> 3, part = lane & 7;
    u32x4 ov[2][2], zv[2][2], pv[2][4][2]; float msv[2][4], lsv[2][4];
#pragma unroll
    for (int r = 0; r < 2; ++r) { const int m = m0 + r * mstep; if (m >= MTOK) continue;
        const int b = m >> 13, t = m & 8191, nv = min(3, t >> 8), bh = b * 8 + h;
        const size_t off = (size_t)m * 1024 + h * 128 + 16 * part;
        const bf16_t* ob = (const bf16_t*)(p.ws + WS_T1) + off; const bf16_t* zb = proj + 3 * SEC + off;
        ov[r][0] = *(const u32x4*)ob; ov[r][1] = *(const u32x4*)(ob + 8); zv[r][0] = *(const u32x4*)zb; zv[r][1] = *(const u32x4*)(zb + 8);
#pragma unroll
        for (int s = 0; s < 4; ++s) { const bool ok = (s == 3) || (s < nv);
            msv[r][s] = -1e30f; lsv[r][s] = 0.f; pv[r][s][0] = (u32x4){0u, 0u, 0u, 0u}; pv[r][s][1] = (u32x4){0u, 0u, 0u, 0u};
            if (ok) { const float* mlp = ML + ((size_t)s * 32 * NT + (size_t)bh * NT + t) * 2; msv[r][s] = mlp[0]; lsv[r][s] = mlp[1];
                const bf16_t* pp = proj + (size_t)(s == 3 ? 6 : s) * SEC + off; pv[r][s][0] = *(const u32x4*)pp; pv[r][s][1] = *(const u32x4*)(pp + 8); } } }
#pragma unroll
    for (int r = 0; r < 2; ++r) { const int m = m0 + r * mstep; if (m >= MTOK) continue;
        {
            const u32x4 o0 = ov[r][0], o1 = ov[r][1], z0 = zv[r][0], z1 = zv[r][1];
            float o[16] = {bflo(o0.x), bfhi(o0.x), bflo(o0.y), bfhi(o0.y), bflo(o0.z), bfhi(o0.z), bflo(o0.w), bfhi(o0.w), bflo(o1.x), bfhi(o1.x), bflo(o1.y), bfhi(o1.y), bflo(o1.z), bfhi(o1.z), bflo(o1.w), bfhi(o1.w)};
            float z[16] = {bflo(z0.x), bfhi(z0.x), bflo(z0.y), bfhi(z0.y), bflo(z0.z), bfhi(z0.z), bflo(z0.w), bfhi(z0.w), bflo(z1.x), bfhi(z1.x), bflo(z1.y), bfhi(z1.y), bflo(z1.z), bfhi(z1.z), bflo(z1.w), bfhi(z1.w)};
            float ss = 0.f;
#pragma unroll
            for (int e = 0; e < 16; ++e) ss += o[e] * o[e];
            ss += __shfl_xor(ss, 1); ss += __shfl_xor(ss, 2); ss += __shfl_xor(ss, 4);
            const float rstd = rsqrtf(ss * (1.f / 128.f) + RMS_EPS);
            const float* ow = p.in[6] + 16 * part;
            float y[16];
#pragma unroll
            for (int e = 0; e < 16; ++e) y[e] = o[e] * rstd * ow[e] * siluf_(z[e]);
            u32x4 w0, w1;
            w0.x = cvt_pk_bf16(y[0], y[1]); w0.y = cvt_pk_bf16(y[2], y[3]); w0.z = cvt_pk_bf16(y[4], y[5]); w0.w = cvt_pk_bf16(y[6], y[7]);
            w1.x = cvt_pk_bf16(y[8], y[9]); w1.y = cvt_pk_bf16(y[10], y[11]); w1.z = cvt_pk_bf16(y[12], y[13]); w1.w = cvt_pk_bf16(y[14], y[15]);
            bf16_t* ya = (bf16_t*)p.out + (size_t)m * 2048 + h * 128 + 16 * part;
            *(u32x4*)ya = w0; *(u32x4*)(ya + 8) = w1;
        }
        {
            float M = -1e30f;
#pragma unroll
            for (int s = 0; s < 4; ++s) M = fmaxf(M, msv[r][s]);
            float acc[16];
#pragma unroll
            for (int e = 0; e < 16; ++e) acc[e] = 0.f;
            float den = 0.f;
#pragma unroll
            for (int s = 0; s < 4; ++s) { const float w = __builtin_amdgcn_exp2f(msv[r][s] - M) * lsv[r][s]; den += w;
                const u32x4 a0 = pv[r][s][0], a1 = pv[r][s][1];
                acc[0] += w * bflo(a0.x); acc[1] += w * bfhi(a0.x); acc[2] += w * bflo(a0.y); acc[3] += w * bfhi(a0.y); acc[4] += w * bflo(a0.z); acc[5] += w * bfhi(a0.z); acc[6] += w * bflo(a0.w); acc[7] += w * bfhi(a0.w);
                acc[8] += w * bflo(a1.x); acc[9] += w * bfhi(a1.x); acc[10] += w * bflo(a1.y); acc[11] += w * bfhi(a1.y); acc[12] += w * bflo(a1.z); acc[13] += w * bfhi(a1.z); acc[14] += w * bflo(a1.w); acc[15] += w * bfhi(a1.w); }
            const float inv = 1.f / den;
            u32x4 w0, w1;
            w0.x = cvt_pk_bf16(acc[0] * inv, acc[1] * inv); w0.y = cvt_pk_bf16(acc[2] * inv, acc[3] * inv); w0.z = cvt_pk_bf16(acc[4] * inv, acc[5] * inv); w0.w = cvt_pk_bf16(acc[6] * inv, acc[7] * inv);
            w1.x = cvt_pk_bf16(acc[8] * inv, acc[9] * inv); w1.y = cvt_pk_bf16(acc[10] * inv, acc[11] * inv); w1.z = cvt_pk_bf16(acc[12] * inv, acc[13] * inv); w1.w = cvt_pk_bf16(acc[14] * inv, acc[15] * inv);
            bf16_t* yb = (bf16_t*)p.out + (size_t)m * 2048 + 1024 + h * 128 + 16 * part;
            *(u32x4*)yb = w0; *(u32x4*)(yb + 8) = w1;
        }
    }
}
__device__ __forceinline__ void grid_bar(unsigned* ctr, unsigned nblocks) {
    asm volatile("s_waitcnt vmcnt(0)" ::: "memory");
    __syncthreads();
    if (threadIdx.x == 0) {
        __builtin_amdgcn_fence(__ATOMIC_RELEASE, "agent");
        asm volatile("s_waitcnt vmcnt(0)" ::: "memory");
        __hip_atomic_fetch_add(ctr, 1u, __ATOMIC_RELAXED, __HIP_MEMORY_SCOPE_AGENT);
        while (__hip_atomic_load(ctr, __ATOMIC_RELAXED, __HIP_MEMORY_SCOPE_AGENT) < nblocks) __builtin_amdgcn_s_sleep(2);
        __builtin_amdgcn_fence(__ATOMIC_ACQUIRE, "agent");
        asm volatile("s_waitcnt vmcnt(0)" ::: "memory");
    }
    __syncthreads();
}
__device__ __forceinline__ void sub_wait(unsigned* ctr, unsigned target) {
    __syncthreads();
    if (threadIdx.x == 0) {
        while (__hip_atomic_load(ctr, __ATOMIC_RELAXED, __HIP_MEMORY_SCOPE_AGENT) < target) __builtin_amdgcn_s_sleep(8);
        __builtin_amdgcn_fence(__ATOMIC_ACQUIRE, "agent");
        asm volatile("s_waitcnt vmcnt(0)" ::: "memory");
    }
    __syncthreads();
}
__global__ void __launch_bounds__(512, 2) fwd_kernel(Params p) {
    extern __shared__ __attribute__((aligned(16))) unsigned char lds[];
    const int tid = threadIdx.x, lane = tid & 63, wave = tid >> 6;
    const int G = gridDim.x, bid = blockIdx.x;
    unsigned char* ws = p.ws; unsigned char* dob = (unsigned char*)p.out;
    bf16_t* proj = (bf16_t*)(ws + WS_PROJ);
    PG8_LAS unsigned char* ldsa = (PG8_LAS unsigned char*)lds;
    const int lo = p.ph_lo, hi = p.ph_hi;
#ifdef PH_MASK
#define IN(k) (((PH_MASK >> (k)) & 1) && lo <= (k) && (k) < hi)
#else
#define IN(k) (lo <= (k) && (k) < hi)
#endif
#define SEAM(k) do { if (IN(k) && IN((k) + 1)) { if ((k) == 0) cg::this_grid().sync(); else grid_bar((unsigned*)(ws + WS_CNT) + 64 * (k), (unsigned)G); } } while (0)

    if (IN(0)) { phase0(p, lds); }
    SEAM(0);
    if (IN(1)) {
        pg8::Gemm g{(const bf16_t*)dob, (const bf16_t*)(ws + WS_WIN), MTOK, NPROJ, DM}; pg8::StaticOrder S; S.init(MTOK, NPROJ, G, bid);
        pg8::EpiSplit E{proj};
        pg8::gemm_phase<pg8::EpiSplit, pg8::StaticOrder, true, true>(ldsa, g, S, E);
    }
    SEAM(1);
    if (IN(2)) {
        for (int base = bid * 16; base < 4096; base += G * 16) {
            const int hh = (base >> 7) & 7; float* cwl = (float*)(lds + GP_CW);
            for (int i = tid; i < 1536; i += 512) { const int j = i / 384, r = i % 384; cwl[i] = p.in[3][j * 3072 + (r >> 7) * 1024 + hh * 128 + (r & 127)]; }
            u32x4 raw[3][2][4]; float gpre = 0.f, bpre = 0.f;
            GP_ISSUE(raw, gpre, bpre, base);
            for (int k = 0; k < 16; ++k) gdn_prep_item(p, lds, base + k, raw, gpre, bpre, k < 15 ? base + k + 1 : -1);
            __syncthreads();
        }
    }
    SEAM(2);
    if (IN(3)) {
        unsigned* cnt = (unsigned*)(ws + WS_CNT) + 16 * (p.flags >> 8);
        const unsigned NM = (unsigned)(G - 32);
        if (bid < 32) {
            if (!(p.flags & 4)) scan_bh(p, lds, bid);
            sub_wait(cnt + 8, NM);
        } else {
            if (!(p.flags & 1)) for (int it = bid - 32; it < 1024; it += G - 32) moba_prep_item(p, lds, it);
            grid_bar(cnt + 4, NM);
            float* sc = (float*)(lds + wave * 4352);
            for (int it = (bid - 32) * 8 + wave; it < 32 * 256; it += (G - 32) * 8) route_item(p, sc, it, lane);
            grid_bar(cnt + 8, NM);
        }
        volatile int* misc = (volatile int*)(lds + AT_MISC);
        for (;;) {
            if (tid == 0) misc[0] = (int)atomicAdd(cnt, 1u);
            __syncthreads();
            const int it = misc[0];
            __syncthreads();
            if (it >= 1024 || (p.flags & 8)) break;
            attn_item(p, lds, it);
        }
        if (bid >= 32 && !(p.flags >> 8)) {
            float* scr = (float*)(lds + wave * 8704);
            constexpr int I_GU = 32 * 352, I_DN = 88 * 64;
            for (int itw = (bid - 32) * 8 + wave; itw < I_GU + I_DN; itw += (G - 32) * 8) {
                int r = itw;
                if (r < I_GU) { const int kb = r / 352, nb = r % 352, n0 = 32 * nb, pn = n0 >> 8, bj = (n0 >> 7) & 1, j0 = n0 & 127;
                    const float* W = bj ? p.in[15] : p.in[14];
                    transpose_item(W + (size_t)(64 * kb) * DFF + 128 * pn + j0, DFF, (bf16_t*)(ws + WS_WGU) + (size_t)n0 * 2048 + 64 * kb, 2048, p.in[13] + 64 * kb, scr, lane); }
                else { r -= I_GU; const int kb = r / 64, nb = r % 64;
                    transpose_item(p.in[16] + (size_t)(64 * kb) * 2048 + 32 * nb, 2048, (bf16_t*)(ws + WS_WDN) + (size_t)(32 * nb) * DFF + 64 * kb, DFF, nullptr, scr, lane); }
            }
        }
    }
    SEAM(3);
    if (IN(4)) {
        for (int m = bid * 8 + wave; m < MTOK; m += 2 * G * 8) combine_rows(p, m, G * 8, lane);
    }
    SEAM(4);
    if (IN(5)) {
        pg8::Gemm g{(const bf16_t*)dob, (const bf16_t*)(ws + WS_WBG), MTOK, DM, DM}; pg8::StaticOrder S; S.init(MTOK, DM, G, bid);
        pg8::EpiGateMix E{proj + 7 * SEC, proj};
        pg8::gemm_phase<pg8::EpiGateMix, pg8::StaticOrder, true, true>(ldsa, g, S, E);
    }
    SEAM(5);
    if (IN(6)) {
        pg8::Gemm g{proj, (const bf16_t*)(ws + WS_WOUT), MTOK, DM, DM}; pg8::StaticOrder S; S.init(MTOK, DM, G, bid);
        pg8::EpiH1 E{p.in[0], p.out, proj + 5 * SEC, (float*)(ws + WS_MISC)};
        pg8::gemm_phase<pg8::EpiH1, pg8::StaticOrder, true, true>(ldsa, g, S, E);
    }
    SEAM(6);
    if (IN(7)) {
        pg8::Gemm g{proj + 5 * SEC, (const bf16_t*)(ws + WS_WGU), MTOK, NPROJ, DM}; pg8::StaticOrder S; S.init(MTOK, NPROJ, G, bid);
        pg8::EpiSwiGLU E{(const float*)(ws + WS_MISC), proj + 7 * SEC};
        pg8::gemm_phase<pg8::EpiSwiGLU, pg8::StaticOrder, true, true>(ldsa, g, S, E);
    }
    SEAM(7);
    if (IN(8)) {
        pg8::Gemm g{proj + 7 * SEC, (const bf16_t*)(ws + WS_WDN), MTOK, DM, DFF}; pg8::StaticOrder S; S.init(MTOK, DM, G, bid);
        pg8::EpiDown E{p.out};
        pg8::gemm_phase<pg8::EpiDown, pg8::StaticOrder, true, true>(ldsa, g, S, E);
    }
#undef IN
#undef SEAM
}

extern "C" void kernel_launch(void* const* d_in, const int* in_sizes, int n_in, void* d_out, int out_size, void* d_ws, size_t ws_size, hipStream_t stream) {
    static int grid = 0;
    if (grid == 0) {
        if (n_in != 17 || out_size != MTOK * DM || ws_size < 16 * SECB) { fprintf(stderr, "kernel_launch: unexpected shapes (n_in %d out %d ws %zu)\n", n_in, out_size, ws_size); grid = -1; return; }
        int dev = 0, cus = 0, per_cu = 0;
        hipGetDevice(&dev); hipDeviceGetAttribute(&cus, hipDeviceAttributeMultiprocessorCount, dev);
        if (hipFuncSetAttribute((const void*)fwd_kernel, hipFuncAttributeMaxDynamicSharedMemorySize, LDS_BYTES) != hipSuccess) { fprintf(stderr, "kernel_launch: hipFuncSetAttribute failed\n"); grid = -1; return; }
        if (hipOccupancyMaxActiveBlocksPerMultiprocessor(&per_cu, (const void*)fwd_kernel, 512, LDS_BYTES) != hipSuccess || per_cu < 1) { fprintf(stderr, "kernel_launch: occupancy query says %d\n", per_cu); per_cu = 1; }
        (void)hipGetLastError();
        grid = cus * 1;
    }
    if (grid < 0) return;
    Params p{};
    for (int i = 0; i < 17; ++i) p.in[i] = (const float*)d_in[i];
    p.out = (float*)d_out; p.ws = (unsigned char*)d_ws;
    static const int prog[][3] = LAUNCH_PROG;
    for (unsigned i = 0; i < sizeof(prog) / sizeof(prog[0]); ++i) {
        p.ph_lo = prog[i][0]; p.ph_hi = prog[i][1]; p.flags = prog[i][2];
        void* args[] = {&p};
        hipError_t e = hipLaunchCooperativeKernel((const void*)fwd_kernel, dim3(grid), dim3(512), args, LDS_BYTES, stream);
        if (e != hipSuccess) fprintf(stderr, "cooperative launch failed: %s (grid %d)\n", hipGetErrorString(e), grid);
    }
}
```

```cpp
#include <hip/hip_runtime.h>
#include <hip/hip_cooperative_groups.h>
#include <cstdio>
#include <cstdint>
namespace cg = cooperative_groups;


#ifndef LAUNCH_PROG
#define LAUNCH_PROG {{0, 9, 0}}
#endif
constexpr int NB = 4, NT = 8192, DM = 2048, NH = 8, HD = 128, MTOK = NB * NT;
constexpr int DFF = 5632, NPROJ = 11264, WIN_LD = 11280;
constexpr size_t SEC = (size_t)MTOK * 1024;
constexpr size_t SECB = SEC * 2;
constexpr size_t WS_WIN = 0;
constexpr size_t WS_WBG = WS_WIN + (size_t)NPROJ * DM * 2;
constexpr size_t WS_WBM = WS_WBG + (size_t)DM * 1024 * 2;
constexpr size_t WS_WOUT = WS_WBM + (size_t)DM * 1024 * 2;
constexpr size_t WS_WGU = WS_WOUT + (size_t)DM * DM * 2;
constexpr size_t WS_WDN = WS_WGU + (size_t)NPROJ * DM * 2;
constexpr size_t WS_MISC = WS_WDN + (size_t)DM * DFF * 2;
constexpr size_t WS_CNT = WS_MISC + (size_t)MTOK * 4;
constexpr size_t WS_PROJ = 2 * SECB;
constexpr size_t WS_T0 = 13 * SECB, WS_T1 = 14 * SECB, WS_T2 = 15 * SECB;
static_assert(WS_CNT + 4096 <= WS_PROJ, "weights + misc fit under proj");
constexpr size_t REC_BYTES = 57344;
constexpr size_t DO_SMALL = (size_t)4096 * REC_BYTES;
constexpr size_t DO_BETA = DO_SMALL, DO_G = DO_BETA + (1u << 20), DO_ML = DO_G + (1u << 20), DO_SEL = DO_ML + (8u << 20),
                 DO_KMEAN = DO_SEL + (1u << 20), DO_BIAS = DO_KMEAN + (512u << 10), DO_GL = DO_BIAS + (256u << 10);
static_assert(DO_GL + 16384 <= (size_t)MTOK * DM * 4, "small stuff fits in d_out");
constexpr int LDS_BYTES = 153600;
constexpr float RMS_EPS = 1e-6f;

typedef unsigned short bf16_t;
typedef short bf16x8 __attribute__((ext_vector_type(8)));
typedef float f32x4 __attribute__((ext_vector_type(4)));
typedef float f32x16 __attribute__((ext_vector_type(16)));
typedef unsigned u32x4 __attribute__((ext_vector_type(4)));
typedef unsigned u32x2 __attribute__((ext_vector_type(2)));

__device__ __forceinline__ unsigned cvt_pk_bf16(float lo, float hi) { unsigned r; asm volatile("v_cvt_pk_bf16_f32 %0, %1, %2" : "=v"(r) : "v"(lo), "v"(hi)); return r; }
__device__ __forceinline__ float bflo(unsigned w) { return __uint_as_float(w << 16); }
__device__ __forceinline__ float bfhi(unsigned w) { return __uint_as_float(w & 0xffff0000u); }
__device__ __forceinline__ float bf1(bf16_t b) { return __uint_as_float((unsigned)b << 16); }
__device__ __forceinline__ unsigned f2bf(float f) { unsigned u = __float_as_uint(f); return (u + 0x7fffu + ((u >> 16) & 1u)) >> 16; }
__device__ __forceinline__ float sigmoidf_(float x) { return __builtin_amdgcn_rcpf(1.f + __expf(-x)); }
__device__ __forceinline__ float siluf_(float x) { return x * __builtin_amdgcn_rcpf(1.f + __expf(-x)); }
__device__ __forceinline__ int perm16(int p) { return (p & 3) + ((p >> 2) & 1) * 8 + ((p >> 3) & 1) * 4; }
__device__ __forceinline__ float wave_sum(float v) {
#pragma unroll
    for (int o = 1; o < 64; o <<= 1) v += __shfl_xor(v, o);
    return v;
}
#define LDS_WAIT() asm volatile("s_waitcnt lgkmcnt(0)" ::: "memory")
struct Params { const float* in[17]; float* out; unsigned char* ws; int ph_lo, ph_hi, flags, pad; };
namespace pg8 {
#define PG8_LAS __attribute__((address_space(3)))
typedef unsigned short bf16_t;
typedef short bf16x8 __attribute__((ext_vector_type(8)));
typedef float f32x4 __attribute__((ext_vector_type(4)));
typedef unsigned u32x4 __attribute__((ext_vector_type(4)));
constexpr int BM = 256, BK = 64, HALF = 128, HTB = HALF * BK * 2  , STAGE_BYTES = 8 * HTB, NXCD = 8, WGM = 8;

__host__ __device__ __forceinline__ int lds_byte(int r, int c) { const int st = (r >> 4) * 2 + (c >> 5), rr = r & 15, cc = c & 31, ob = rr * 64 + cc * 2; return st * 1024 + (ob ^ (((ob >> 9) & 1) << 5)); }
__host__ __device__ __forceinline__ void stage_rc(int b, int& R, int& C) { const int st = b / 1024, sb = b % 1024, swz = sb ^ (((sb >> 9) & 1) << 5); R = (st >> 1) * 16 + swz / 64; C = (st & 1) * 32 + (swz % 64) / 2; }
__host__ __device__ __forceinline__ int perm32(int rho) { const int n = rho >> 4, i = rho & 15; return 8 * (i >> 2) + 4 * n + (i & 3); }

struct Unit { int pm, pn; };
struct Gemm { const bf16_t* A; const bf16_t* Bt; int M, N, K; };

struct StaticOrder {
    int nM, nN, nwg, G, c;
    __host__ __device__ void init(int M, int N, int G_, int c_) { nM = M / BM; nN = N / BM; nwg = nM * nN; G = G_; c = c_; }
    __host__ __device__ bool next(int i, Unit& u) const {
        const long L = (long)i * G + c; if (L >= nwg) return false;
        int wgid = (int)L; { const int q = nwg / NXCD, r = nwg % NXCD, xcd = wgid % NXCD, off = wgid / NXCD; wgid = (xcd < r ? xcd * (q + 1) : r * (q + 1) + (xcd - r) * q) + off; }
        const int nig = WGM * nN, gid = wgid / nig, fm = gid * WGM, gsz = (nM - fm) < WGM ? (nM - fm) : WGM;
        u.pm = fm + ((wgid % nig) % gsz); u.pn = (wgid % nig) / gsz; return true;
    }
    __device__ __forceinline__ void a_ready(const Unit&) const {}
    __device__ __forceinline__ void done(const Unit&) const {}
};

struct EpiSplit {
    static constexpr bool PERM = true, AFTER_DRAIN = false, MID = false;
    bf16_t* O;
    __device__ __forceinline__ void operator()(const f32x4 (&acc)[2][2][4][2], const Unit& u, int wr, int wc, int fr, int fq) const {
        const int row0 = u.pm * BM + wr * 64 + fr; int colt = u.pn * BM; const int sec = colt >> 10; colt &= 1023;
        bf16_t* base = O + (size_t)sec * SEC; const int col0 = colt + wc * 32 + 8 * fq;
#pragma unroll
        for (int ai = 0; ai < 2; ++ai)
#pragma unroll
            for (int m = 0; m < 4; ++m) { bf16_t* rowp = base + (size_t)(row0 + ai * HALF + m * 16) * 1024 + col0;
#pragma unroll
                for (int bj = 0; bj < 2; ++bj) { const f32x4 v0 = acc[ai][bj][m][0], v1 = acc[ai][bj][m][1];
                    u32x4 w; w.x = cvt_pk_bf16(v0[0], v0[1]); w.y = cvt_pk_bf16(v0[2], v0[3]); w.z = cvt_pk_bf16(v1[0], v1[1]); w.w = cvt_pk_bf16(v1[2], v1[3]);
                    *(u32x4*)(rowp + bj * HALF) = w; } }
    }
};
struct EpiGateMix {
    static constexpr bool PERM = true, AFTER_DRAIN = false, MID = true;
    const bf16_t* gate; bf16_t* mix;
    static __device__ __forceinline__ float cl(float x) { return fminf(fmaxf(x, -30.f), 30.f); }
    __device__ __forceinline__ void mid(f32x4 (&acc)[2][2][4][2], const Unit& u, int wr, int wc, int fr, int fq) const {
        int fro = fr; asm volatile("" : "+v"(fro));
        const int row0 = u.pm * BM + wr * 64 + fro;
#pragma unroll
        for (int ai = 0; ai < 2; ++ai)
#pragma unroll
            for (int m = 0; m < 4; ++m) { const size_t row = (size_t)(row0 + ai * HALF + m * 16);
#pragma unroll
                for (int bj = 0; bj < 2; ++bj) { const int col = u.pn * BM + bj * HALF + wc * 32 + 8 * fq;
                    const bf16_t* gp = gate + (size_t)(col >> 10) * SEC + row * 1024 + (col & 1023);
                    const u32x4 ga = *(const u32x4*)gp, gb = *(const u32x4*)(gp + 2 * SEC);
                    float ea[8] = {bflo(ga.x), bfhi(ga.x), bflo(ga.y), bfhi(ga.y), bflo(ga.z), bfhi(ga.z), bflo(ga.w), bfhi(ga.w)};
                    float eb[8] = {bflo(gb.x), bfhi(gb.x), bflo(gb.y), bfhi(gb.y), bflo(gb.z), bfhi(gb.z), bflo(gb.w), bfhi(gb.w)};
                    float r[8];
#pragma unroll
                    for (int e = 0; e < 8; ++e) r[e] = (1.f + __expf(-cl(eb[e]))) * __builtin_amdgcn_rcpf(1.f + __expf(-cl(ea[e])));
                    acc[ai][bj][m][0][0] *= r[0]; acc[ai][bj][m][0][1] *= r[1]; acc[ai][bj][m][0][2] *= r[2]; acc[ai][bj][m][0][3] *= r[3];
                    acc[ai][bj][m][1][0] *= r[4]; acc[ai][bj][m][1][1] *= r[5]; acc[ai][bj][m][1][2] *= r[6]; acc[ai][bj][m][1][3] *= r[7]; }
                if (m == 3) __builtin_amdgcn_sched_barrier(0); }
    }
    __device__ __forceinline__ void operator()(const f32x4 (&acc)[2][2][4][2], const Unit& u, int wr, int wc, int fr, int fq) const {
        const int row0 = u.pm * BM + wr * 64 + fr;
#pragma unroll
        for (int ai = 0; ai < 2; ++ai)
#pragma unroll
            for (int m = 0; m < 4; ++m) { const size_t row = (size_t)(row0 + ai * HALF + m * 16);
#pragma unroll
                for (int bj = 0; bj < 2; ++bj) { const int col = u.pn * BM + bj * HALF + wc * 32 + 8 * fq;
                    const u32x4 gw = *(const u32x4*)(gate + (size_t)(2 + (col >> 10)) * SEC + row * 1024 + (col & 1023));
                    const f32x4 v0 = acc[ai][bj][m][0], v1 = acc[ai][bj][m][1];
                    float r[8];
                    r[0] = v0[0] * sigmoidf_(cl(bflo(gw.x))); r[1] = v0[1] * sigmoidf_(cl(bfhi(gw.x))); r[2] = v0[2] * sigmoidf_(cl(bflo(gw.y))); r[3] = v0[3] * sigmoidf_(cl(bfhi(gw.y)));
                    r[4] = v1[0] * sigmoidf_(cl(bflo(gw.z))); r[5] = v1[1] * sigmoidf_(cl(bfhi(gw.z))); r[6] = v1[2] * sigmoidf_(cl(bflo(gw.w))); r[7] = v1[3] * sigmoidf_(cl(bfhi(gw.w)));
                    u32x4 w; w.x = cvt_pk_bf16(r[0], r[1]); w.y = cvt_pk_bf16(r[2], r[3]); w.z = cvt_pk_bf16(r[4], r[5]); w.w = cvt_pk_bf16(r[6], r[7]);
                    *(u32x4*)(mix + row * 2048 + col) = w; } }
    }
};
struct EpiH1 {
    static constexpr bool PERM = true, AFTER_DRAIN = false, MID = false;
    const float* x; float* h1; bf16_t* h1b; float* rowsq;
    __device__ __forceinline__ void operator()(const f32x4 (&acc)[2][2][4][2], const Unit& u, int wr, int wc, int fr, int fq) const {
        const int row0 = u.pm * BM + wr * 64 + fr;
#pragma unroll
        for (int ai = 0; ai < 2; ++ai)
#pragma unroll
            for (int m = 0; m < 4; ++m) { const size_t row = (size_t)(row0 + ai * HALF + m * 16); float ss = 0.f;
#pragma unroll
                for (int bj = 0; bj < 2; ++bj) { const int col = u.pn * BM + bj * HALF + wc * 32 + 8 * fq;
                    const float* xp = x + row * 2048 + col; float* hp = h1 + row * 2048 + col;
                    const f32x4 a0 = *(const f32x4*)xp + acc[ai][bj][m][0], a1 = *(const f32x4*)(xp + 4) + acc[ai][bj][m][1];
                    *(f32x4*)hp = a0; *(f32x4*)(hp + 4) = a1;
                    ss += a0[0] * a0[0] + a0[1] * a0[1] + a0[2] * a0[2] + a0[3] * a0[3] + a1[0] * a1[0] + a1[1] * a1[1] + a1[2] * a1[2] + a1[3] * a1[3];
                    u32x4 w; w.x = cvt_pk_bf16(a0[0], a0[1]); w.y = cvt_pk_bf16(a0[2], a0[3]); w.z = cvt_pk_bf16(a1[0], a1[1]); w.w = cvt_pk_bf16(a1[2], a1[3]);
                    *(u32x4*)(h1b + row * 2048 + col) = w; }
                ss += __shfl_xor(ss, 16); ss += __shfl_xor(ss, 32);
                if (fq == 0) atomicAdd(rowsq + row, ss); }
    }
};
struct EpiSwiGLU {
    static constexpr bool PERM = true, AFTER_DRAIN = false, MID = false;
    const float* rowsq; bf16_t* hid;
    __device__ __forceinline__ void operator()(const f32x4 (&acc)[2][2][4][2], const Unit& u, int wr, int wc, int fr, int fq) const {
        const int row0 = u.pm * BM + wr * 64 + fr; const int col = u.pn * HALF + wc * 32 + 8 * fq;
#pragma unroll
        for (int ai = 0; ai < 2; ++ai)
#pragma unroll
            for (int m = 0; m < 4; ++m) { const size_t row = (size_t)(row0 + ai * HALF + m * 16);
                const float rstd = rsqrtf(rowsq[row] * (1.f / 2048.f) + RMS_EPS);
                float r[8];
#pragma unroll
                for (int n = 0; n < 2; ++n)
#pragma unroll
                    for (int e = 0; e < 4; ++e) { const float g = acc[ai][0][m][n][e] * rstd, up = acc[ai][1][m][n][e] * rstd; r[n * 4 + e] = siluf_(g) * up; }
                u32x4 w; w.x = cvt_pk_bf16(r[0], r[1]); w.y = cvt_pk_bf16(r[2], r[3]); w.z = cvt_pk_bf16(r[4], r[5]); w.w = cvt_pk_bf16(r[6], r[7]);
                *(u32x4*)(hid + row * DFF + col) = w; }
    }
};
struct EpiDown {
    static constexpr bool PERM = true, AFTER_DRAIN = false, MID = false;
    float* out;
    __device__ __forceinline__ void operator()(const f32x4 (&acc)[2][2][4][2], const Unit& u, int wr, int wc, int fr, int fq) const {
        const int row0 = u.pm * BM + wr * 64 + fr;
#pragma unroll
        for (int ai = 0; ai < 2; ++ai)
#pragma unroll
            for (int m = 0; m < 4; ++m) { const size_t row = (size_t)(row0 + ai * HALF + m * 16);
#pragma unroll
                for (int bj = 0; bj < 2; ++bj) { const int col = u.pn * BM + bj * HALF + wc * 32 + 8 * fq; float* op = out + row * 2048 + col;
                    const f32x4 a0 = *(const f32x4*)op + acc[ai][bj][m][0], a1 = *(const f32x4*)(op + 4) + acc[ai][bj][m][1];
                    *(f32x4*)op = a0; *(f32x4*)(op + 4) = a1; } }
    }
};
template <class Epi, class Sched, bool ALIGN_EPI = false, bool SP2 = false>
__device__ __forceinline__ void gemm_phase(PG8_LAS unsigned char* lds, const Gemm g, const Sched& S, const Epi& E) {
    const int tid = threadIdx.x, wid = __builtin_amdgcn_readfirstlane(tid >> 6), lane = tid & 63, wr = wid >> 2, wc = wid & 3, fr = lane & 15, fq = lane >> 4;
    const int K = g.K, nt = K / BK;
    unsigned voffA[2], voffB[2];
#pragma unroll
    for (int i = 0; i < 2; ++i) { int R, C; stage_rc(tid * 16 + i * 8192, R, C); const int Rb = Epi::PERM ? ((R & ~31) + perm32(R & 31)) : R;
        voffA[i] = (unsigned)(R * K + C) * 2u; voffB[i] = (unsigned)(Rb * K + C) * 2u; }
    const size_t kstep = (size_t)(BK * 2);
    const size_t hstep = (size_t)HALF * K * 2;
    const size_t tstep = 2 * hstep;
    const unsigned ldsw = (unsigned)wid * 1024u;
    const int aoff = lds_byte(wr * 64 + fr, fq * 8), boff = lds_byte(wc * 32 + fr, fq * 8);
#define PG8_SA(b, h) (((b) * 2 + (h)) * HTB)
#define PG8_SB(b, h) ((4 + (b) * 2 + (h)) * HTB)
#define PG8_STAGE(bufoff, gbase, voff) do { _Pragma("unroll") for (int _i = 0; _i < 2; ++_i) \
        __builtin_amdgcn_global_load_lds((const unsigned*)((const char*)(gbase) + (voff)[_i]), (PG8_LAS unsigned*)(lds + (bufoff) + ldsw + _i * 8192), 16, 0, 0); } while (0)
#define PG8_LDA(dst, b, h) do { _Pragma("unroll") for (int m = 0; m < 4; ++m) _Pragma("unroll") for (int k = 0; k < 2; ++k) dst[m][k] = *(const PG8_LAS bf16x8*)(lds + PG8_SA(b, h) + aoff + m * 2048 + k * 1024); } while (0)
#define PG8_LDB(dst, b, h) do { _Pragma("unroll") for (int n = 0; n < 2; ++n) _Pragma("unroll") for (int k = 0; k < 2; ++k) dst[n][k] = *(const PG8_LAS bf16x8*)(lds + PG8_SB(b, h) + boff + n * 2048 + k * 1024); } while (0)
#define PG8_MMA(ai, bj, At, Bt) do { __builtin_amdgcn_s_setprio(1); _Pragma("unroll") for (int m = 0; m < 4; ++m) _Pragma("unroll") for (int n = 0; n < 2; ++n) _Pragma("unroll") for (int k = 0; k < 2; ++k) \
        acc[ai][bj][m][n] = __builtin_amdgcn_mfma_f32_16x16x32_bf16(Bt[n][k], At[m][k], acc[ai][bj][m][n], 0, 0, 0); __builtin_amdgcn_s_setprio(0); } while (0)
#define PG8_WAIT_V(n) asm volatile("s_waitcnt vmcnt(" #n ")" ::: "memory")
#define PG8_WAIT_L(n) asm volatile("s_waitcnt lgkmcnt(" #n ")" ::: "memory")
#define PG8_BAR __builtin_amdgcn_s_barrier()
#define PG8_SCHED __builtin_amdgcn_sched_barrier(0)
    Unit cur, nxt; int ui = 0;
    if (!S.next(0, cur)) return;
    f32x4 acc[2][2][4][2];
#pragma unroll
    for (int a = 0; a < 2; ++a)
#pragma unroll
        for (int b = 0; b < 2; ++b)
#pragma unroll
            for (int m = 0; m < 4; ++m)
#pragma unroll
                for (int n = 0; n < 2; ++n) acc[a][b][m][n] = (f32x4){0.f, 0.f, 0.f, 0.f};
    bf16x8 At[4][2], B0[2][2], B1[2][2];
    const char* cA = (const char*)g.A + (size_t)cur.pm * tstep; const char* cB = (const char*)g.Bt + (size_t)cur.pn * tstep;
    S.a_ready(cur);
    if constexpr (SP2) {
        PG8_STAGE(PG8_SB(0, 0), cB, voffB); PG8_STAGE(PG8_SB(0, 1), cB + hstep, voffB); PG8_STAGE(PG8_SA(0, 0), cA, voffA); PG8_STAGE(PG8_SA(0, 1), cA + hstep, voffA);
        if (wr == 1) PG8_BAR;
        PG8_WAIT_V(2); PG8_BAR;
        PG8_STAGE(PG8_SB(1, 0), cB + kstep, voffB); PG8_STAGE(PG8_SA(1, 0), cA + kstep, voffA); PG8_STAGE(PG8_SB(1, 1), cB + hstep + kstep, voffB);
        PG8_WAIT_V(6); PG8_BAR;
    } else {
        PG8_STAGE(PG8_SB(0, 0), cB, voffB); PG8_STAGE(PG8_SA(0, 0), cA, voffA); PG8_STAGE(PG8_SB(0, 1), cB + hstep, voffB); PG8_STAGE(PG8_SA(0, 1), cA + hstep, voffA);
        if (wr == 1) PG8_BAR;
        PG8_WAIT_V(4); PG8_BAR;
        PG8_STAGE(PG8_SB(1, 0), cB + kstep, voffB); PG8_STAGE(PG8_SA(1, 0), cA + kstep, voffA); PG8_STAGE(PG8_SB(1, 1), cB + hstep + kstep, voffB);
        PG8_WAIT_V(6); PG8_BAR;
    }
    for (;;) {
        const bool has_next = S.next(ui + 1, nxt);
        const char* nA = has_next ? (const char*)g.A + (size_t)nxt.pm * tstep : cA; const char* nB = has_next ? (const char*)g.Bt + (size_t)nxt.pn * tstep : cB;
        for (int t = 0; t < nt; t += 2) {
            const bool last = (t == nt - 2);
            const char* a1 = cA + (size_t)(t + 1) * kstep;
            const char* a2 = last ? nA : cA + (size_t)(t + 2) * kstep; const char* b2 = last ? nB : cB + (size_t)(t + 2) * kstep;
            const char* a3 = a2 + kstep; const char* b3 = b2 + kstep;
            if (last && has_next) S.a_ready(nxt);
            if constexpr (Epi::MID) { if (t == (nt >> 1)) E.mid(acc, cur, wr, wc, fr, fq); }
            if constexpr (SP2) {
            PG8_LDB(B0, 0, 0); PG8_LDB(B1, 0, 1); PG8_SCHED; PG8_LDA(At, 0, 0); PG8_STAGE(PG8_SA(1, 1), a1 + hstep, voffA);
            PG8_WAIT_V(8); PG8_WAIT_L(0); PG8_BAR; PG8_MMA(0, 0, At, B0); PG8_MMA(0, 1, At, B1); PG8_BAR; PG8_SCHED;
            PG8_LDA(At, 0, 1); PG8_STAGE(PG8_SB(0, 0), b2, voffB); PG8_STAGE(PG8_SB(0, 1), b2 + hstep, voffB); PG8_STAGE(PG8_SA(0, 0), a2, voffA);
            PG8_WAIT_V(8); PG8_WAIT_L(0); PG8_BAR; PG8_MMA(1, 0, At, B0); PG8_MMA(1, 1, At, B1); PG8_BAR; PG8_SCHED;
            PG8_LDB(B0, 1, 0); PG8_LDB(B1, 1, 1); PG8_SCHED; PG8_LDA(At, 1, 0); PG8_STAGE(PG8_SA(0, 1), a2 + hstep, voffA);
            PG8_WAIT_V(8); PG8_WAIT_L(0); PG8_BAR; PG8_MMA(0, 0, At, B0); PG8_MMA(0, 1, At, B1); PG8_BAR; PG8_SCHED;
            PG8_LDA(At, 1, 1); PG8_STAGE(PG8_SB(1, 0), b3, voffB); PG8_STAGE(PG8_SB(1, 1), b3 + hstep, voffB); PG8_STAGE(PG8_SA(1, 0), a3, voffA);
            PG8_WAIT_V(8); PG8_WAIT_L(0); PG8_BAR; PG8_MMA(1, 0, At, B0); PG8_MMA(1, 1, At, B1); PG8_BAR; PG8_SCHED;
            } else {
            PG8_LDB(B0, 0, 0); PG8_SCHED; PG8_LDA(At, 0, 0); PG8_STAGE(PG8_SA(1, 1), a1 + hstep, voffA);
            PG8_WAIT_L(8); PG8_BAR; PG8_WAIT_L(0); PG8_MMA(0, 0, At, B0); PG8_BAR; PG8_SCHED;
            PG8_LDB(B1, 0, 1); PG8_STAGE(PG8_SB(0, 0), b2, voffB);
            PG8_BAR; PG8_WAIT_L(0); PG8_MMA(0, 1, At, B1); PG8_BAR;
            PG8_LDA(At, 0, 1); PG8_STAGE(PG8_SA(0, 0), a2, voffA);
            PG8_BAR; PG8_WAIT_L(0); PG8_MMA(1, 0, At, B0); PG8_BAR; PG8_SCHED;
            PG8_STAGE(PG8_SB(0, 1), b2 + hstep, voffB);
            PG8_WAIT_V(6); PG8_BAR; PG8_MMA(1, 1, At, B1); PG8_BAR;
            PG8_LDB(B0, 1, 0); PG8_SCHED; PG8_LDA(At, 1, 0); PG8_STAGE(PG8_SA(0, 1), a2 + hstep, voffA);
            PG8_WAIT_L(8); PG8_BAR; PG8_WAIT_L(0); PG8_MMA(0, 0, At, B0); PG8_BAR; PG8_SCHED;
            PG8_LDB(B1, 1, 1); PG8_STAGE(PG8_SB(1, 0), b3, voffB);
            PG8_BAR; PG8_WAIT_L(0); PG8_MMA(0, 1, At, B1); PG8_BAR;
            PG8_LDA(At, 1, 1); PG8_STAGE(PG8_SA(1, 0), a3, voffA);
            PG8_BAR; PG8_WAIT_L(0); PG8_MMA(1, 0, At, B0); PG8_BAR; PG8_SCHED;
            PG8_STAGE(PG8_SB(1, 1), b3 + hstep, voffB);
            PG8_WAIT_V(6); PG8_BAR; PG8_MMA(1, 1, At, B1); PG8_BAR;
            }
        }
        if constexpr (ALIGN_EPI) { if (wr == 0) PG8_BAR; }
        if constexpr (!Epi::AFTER_DRAIN) { E(acc, cur, wr, wc, fr, fq); S.done(cur); }
        if (!has_next) break;
#pragma unroll
        for (int a = 0; a < 2; ++a)
#pragma unroll
            for (int b = 0; b < 2; ++b)
#pragma unroll
                for (int m = 0; m < 4; ++m)
#pragma unroll
                    for (int n = 0; n < 2; ++n) acc[a][b][m][n] = (f32x4){0.f, 0.f, 0.f, 0.f};
        cur = nxt; cA = nA; cB = nB; ++ui;
        if constexpr (ALIGN_EPI) { if (wr == 1) PG8_BAR; }
    }
    PG8_WAIT_V(0);
    if constexpr (!ALIGN_EPI) { if (wr == 0) PG8_BAR; }
    PG8_BAR;
    if constexpr (Epi::AFTER_DRAIN) { E.fused(acc, cur, wr, wc, fr, fq, lds, wid, lane); S.done(cur); }
#undef PG8_SA
#undef PG8_SB
#undef PG8_STAGE
#undef PG8_LDA
#undef PG8_LDB
#undef PG8_MMA
#undef PG8_WAIT_V
#undef PG8_WAIT_L
#undef PG8_BAR
#undef PG8_SCHED
}
}
__device__ __forceinline__ void transpose_item(const float* src, int ld, bf16_t* dst, int K, const float* kscale, float* scr, int lane) {
    float tv[32];
    { int lo = lane; asm volatile("" : "+v"(lo));
      const float* sp = src + (size_t)(lo >> 5) * ld + (lo & 31);
#pragma unroll
      for (int i = 0; i < 32; ++i) tv[i] = sp[(size_t)(2 * i) * ld]; }
    if (kscale) {
#pragma unroll
        for (int i = 0; i < 32; ++i) tv[i] *= kscale[2 * i + (lane >> 5)];
    }
#pragma unroll
    for (int i = 0; i < 32; ++i) { const int kk = 2 * i + (lane >> 5); scr[kk * 33 + (lane & 31)] = tv[i]; }
    LDS_WAIT();
    const int c = lane & 7;
#pragma unroll
    for (int j = 0; j < 4; ++j) { const int n = (lane >> 3) + 8 * j; const float* s = scr + (8 * c) * 33 + n;
        u32x4 o; o.x = cvt_pk_bf16(s[0 * 33], s[1 * 33]); o.y = cvt_pk_bf16(s[2 * 33], s[3 * 33]); o.z = cvt_pk_bf16(s[4 * 33], s[5 * 33]); o.w = cvt_pk_bf16(s[6 * 33], s[7 * 33]);
        *(u32x4*)(dst + (size_t)n * K + 8 * c) = o; }
    LDS_WAIT();
}

__device__ __forceinline__ void phase0(const Params& p, unsigned char* lds) {
    const int tid = threadIdx.x, lane = tid & 63, wave = tid >> 6;
    const int G = gridDim.x, gw = blockIdx.x * 8 + wave, NGW = G * 8, gt = blockIdx.x * 512 + tid, NGT = G * 512;
    unsigned char* ws = p.ws; unsigned char* dob = (unsigned char*)p.out;
    { float* rowsq = (float*)(ws + WS_MISC); for (int i = gt; i < MTOK + 1024; i += NGT) rowsq[i] = 0.f; }
    { float* bias = (float*)(dob + DO_BIAS); const float* rel = p.in[9];
      for (int i = gt; i < 8 * 8192; i += NGT) { const int h = i >> 13, d = i & 8191; int bk;
          if (d < 16) bk = d; else { const float lr = logf(fmaxf((float)d, 16.f) / 16.f) / 4.852030263919617f; bk = 16 + (int)(lr * 16.f); if (bk > 31) bk = 31; }
          bias[i] = rel[bk * 8 + h] * 1.4426950408889634f; } }
    {
        float* scr = (float*)(lds + wave * 8704);
        constexpr int I_IN = 32 * 352, I_B = 16 * 64, I_O = 32 * 64, I_GU = 32 * 352, I_DN = 88 * 64;
        constexpr int NITEMS = I_IN;
        for (int it = gw; it < NITEMS; it += NGW) {
            int r = it;
            if (r < I_IN) { const int kb = r / 352, nb = r % 352, n0 = 32 * nb, sc = n0 + (n0 >= 4096 ? 16 : 0);
                transpose_item(p.in[2] + (size_t)(64 * kb) * WIN_LD + sc, WIN_LD, (bf16_t*)(ws + WS_WIN) + (size_t)n0 * 2048 + 64 * kb, 2048, nullptr, scr, lane); continue; } r -= I_IN;
            if (r < I_B) { const int kb = r / 64, nb = r % 64;
                transpose_item(p.in[10] + (size_t)(64 * kb) * 2048 + 32 * nb, 2048, (bf16_t*)(ws + WS_WBG) + (size_t)(32 * nb) * 2048 + 64 * kb, 2048, nullptr, scr, lane); continue; } r -= I_B;
            if (r < I_B) { const int kb = r / 64, nb = r % 64;
                transpose_item(p.in[11] + (size_t)(64 * kb) * 2048 + 32 * nb, 2048, (bf16_t*)(ws + WS_WBG) + (size_t)(32 * nb) * 2048 + 1024 + 64 * kb, 2048, nullptr, scr, lane); continue; } r -= I_B;
            if (r < I_O) { const int kb = r / 64, nb = r % 64;
                transpose_item(p.in[12] + (size_t)(64 * kb) * 2048 + 32 * nb, 2048, (bf16_t*)(ws + WS_WOUT) + (size_t)(32 * nb) * 2048 + 64 * kb, 2048, nullptr, scr, lane); continue; } r -= I_O;
            if (r < I_GU) { const int kb = r / 352, nb = r % 352, n0 = 32 * nb, pn = n0 >> 8, bj = (n0 >> 7) & 1, j0 = n0 & 127;
                const float* W = bj ? p.in[15] : p.in[14];
                transpose_item(W + (size_t)(64 * kb) * DFF + 128 * pn + j0, DFF, (bf16_t*)(ws + WS_WGU) + (size_t)n0 * 2048 + 64 * kb, 2048, p.in[13] + 64 * kb, scr, lane); continue; } r -= I_GU;
            { const int kb = r / 64, nb = r % 64;
                transpose_item(p.in[16] + (size_t)(64 * kb) * 2048 + 32 * nb, 2048, (bf16_t*)(ws + WS_WDN) + (size_t)(32 * nb) * DFF + 64 * kb, DFF, nullptr, scr, lane); }
        }
    }
    __syncthreads();
    float* Wl = (float*)lds;
    for (int i = tid; i < 2048 * 16; i += 512) { const int k = i >> 4, j = i & 15; Wl[j * 2048 + k] = p.in[2][(size_t)k * WIN_LD + 4096 + j]; }
    __syncthreads();
    {
        bf16_t* un = (bf16_t*)dob;
        float* betab = (float*)(dob + DO_BETA); float* gb = (float*)(dob + DO_G);
        f32x4 nw[8];
#pragma unroll
        for (int j = 0; j < 8; ++j) nw[j] = ((const f32x4*)p.in[1])[lane + 64 * j];
        const int jo = ((lane >> 5) & 1) * 8 + ((lane >> 4) & 1) * 4 + ((lane >> 3) & 1) * 2 + ((lane >> 2) & 1);
        float extra = 0.f, alog = 0.f;
        if (jo >= 8) { alog = expf(p.in[4][jo - 8]); extra = p.in[5][jo - 8]; }
        f32x4 vn[8];
        if (gw < MTOK) { const f32x4* xr = (const f32x4*)(p.in[0] + (size_t)gw * 2048) + lane;
#pragma unroll
            for (int j = 0; j < 8; ++j) vn[j] = xr[64 * j]; }
        for (int m = gw; m < MTOK; m += NGW) {
            f32x4 v[8]; float ss = 0.f;
#pragma unroll
            for (int j = 0; j < 8; ++j) { v[j] = vn[j]; ss += v[j][0] * v[j][0] + v[j][1] * v[j][1] + v[j][2] * v[j][2] + v[j][3] * v[j][3]; }
            if (m + NGW < MTOK) { const f32x4* xr = (const f32x4*)(p.in[0] + (size_t)(m + NGW) * 2048) + lane;
#pragma unroll
                for (int j = 0; j < 8; ++j) vn[j] = xr[64 * j]; }
            const float rstd = rsqrtf(wave_sum(ss) * (1.f / 2048.f) + RMS_EPS);
            u32x2* up = (u32x2*)(un + (size_t)m * 2048) + lane;
#pragma unroll
            for (int j = 0; j < 8; ++j) { v[j] = v[j] * rstd * nw[j]; u32x2 w; w.x = cvt_pk_bf16(v[j][0], v[j][1]); w.y = cvt_pk_bf16(v[j][2], v[j][3]); up[64 * j] = w; }
            float d16[16];
#pragma unroll
            for (int jj = 0; jj < 16; ++jj) { float a = 0.f;
#pragma unroll
                for (int j = 0; j < 8; ++j) { const f32x4 w4 = ((const f32x4*)(Wl + jj * 2048))[lane + 64 * j]; a += v[j][0] * w4[0] + v[j][1] * w4[1] + v[j][2] * w4[2] + v[j][3] * w4[3]; }
                d16[jj] = a; }
            float r8[8], r4[4], r2[2];
            { const bool hi = (lane & 32) != 0;
#pragma unroll
              for (int i = 0; i < 8; ++i) { const float snd = hi ? d16[i] : d16[i + 8], kp = hi ? d16[i + 8] : d16[i]; r8[i] = kp + __shfl_xor(snd, 32); } }
            { const bool hi = (lane & 16) != 0;
#pragma unroll
              for (int i = 0; i < 4; ++i) { const float snd = hi ? r8[i] : r8[i + 4], kp = hi ? r8[i + 4] : r8[i]; r4[i] = kp + __shfl_xor(snd, 16); } }
            { const bool hi = (lane & 8) != 0;
#pragma unroll
              for (int i = 0; i < 2; ++i) { const float snd = hi ? r4[i] : r4[i + 2], kp = hi ? r4[i + 2] : r4[i]; r2[i] = kp + __shfl_xor(snd, 8); } }
            float mine;
            { const bool hi = (lane & 4) != 0; const float snd = hi ? r2[0] : r2[1], kp = hi ? r2[1] : r2[0]; mine = kp + __shfl_xor(snd, 4); }
            mine += __shfl_xor(mine, 2); mine += __shfl_xor(mine, 1);
            const int b = m >> 13, t = m & 8191;
            if ((lane & 3) == 0) {
                if (jo < 8) betab[(size_t)(b * 8 + jo) * NT + t] = 1.f / (1.f + expf(-mine));
                else { const float xx = mine + extra; const float sp = fmaxf(xx, 0.f) + log1pf(expf(-fabsf(xx))); gb[(size_t)(b * 8 + jo - 8) * NT + t] = -alog * sp; }
            }
        }
    }
}
__device__ __forceinline__ void moba_prep_item(const Params& p, unsigned char* lds, int item) {
    const int tid = threadIdx.x, lane = tid & 63, wave = tid >> 6;
    const int n = item & 31, bh = item >> 5, h = bh & 7, b = bh >> 3;
    bf16_t* proj = (bf16_t*)(p.ws + WS_PROJ);
    bf16_t* mq = proj + 4 * SEC; bf16_t* mk = proj + 5 * SEC; const bf16_t* mv = proj + 6 * SEC;
    bf16_t* vl = (bf16_t*)lds;
    float* red = (float*)(lds + 65536);
    const int grp = tid & 15;
    f32x4 qw0 = *(const f32x4*)(p.in[7] + 8 * grp), qw1 = *(const f32x4*)(p.in[7] + 8 * grp + 4);
    f32x4 kw0 = *(const f32x4*)(p.in[8] + 8 * grp), kw1 = *(const f32x4*)(p.in[8] + 8 * grp + 4);
    float ksum[8];
#pragma unroll
    for (int e = 0; e < 8; ++e) ksum[e] = 0.f;
    const float qscale = 0.08838834764831845f * 1.4426950408889634f;
    int tr = tid >> 4; asm volatile("" : "+v"(tr));
#pragma unroll 1
    for (int pb = 0; pb < 2; ++pb) {
    u32x4 qr[4], kr[4], vr[4];
#pragma unroll
    for (int pp = 0; pp < 4; ++pp) { const size_t off = ((size_t)b * NT + n * 256 + 32 * (4 * pb + pp) + tr) * 1024 + h * 128 + 8 * grp;
        qr[pp] = *(const u32x4*)(mq + off); kr[pp] = *(const u32x4*)(mk + off); vr[pp] = *(const u32x4*)(mv + off); }
#pragma unroll
    for (int pp = 0; pp < 4; ++pp) {
        const int ps = 4 * pb + pp;
        const int r = 32 * ps + tr;
        const size_t off = ((size_t)b * NT + n * 256 + r) * 1024 + h * 128 + 8 * grp;
        const u32x4 qv = qr[pp], kv = kr[pp], vv = vr[pp];
        *(u32x4*)(vl + r * 128 + 8 * (grp ^ (((r >> 5) + 2 * ((r >> 2) & 3)) & 7))) = vv;
        float q[8] = {bflo(qv.x), bfhi(qv.x), bflo(qv.y), bfhi(qv.y), bflo(qv.z), bfhi(qv.z), bflo(qv.w), bfhi(qv.w)};
        float k[8] = {bflo(kv.x), bfhi(kv.x), bflo(kv.y), bfhi(kv.y), bflo(kv.z), bfhi(kv.z), bflo(kv.w), bfhi(kv.w)};
        float sq = 0.f, sk = 0.f;
#pragma unroll
        for (int e = 0; e < 8; ++e) { sq += q[e] * q[e]; sk += k[e] * k[e]; }
#pragma unroll
        for (int o = 1; o < 16; o <<= 1) { sq += __shfl_xor(sq, o); sk += __shfl_xor(sk, o); }
        const float rq = rsqrtf(sq * (1.f / 128.f) + RMS_EPS) * qscale, rk = rsqrtf(sk * (1.f / 128.f) + RMS_EPS);
        q[0] *= rq * qw0[0]; q[1] *= rq * qw0[1]; q[2] *= rq * qw0[2]; q[3] *= rq * qw0[3]; q[4] *= rq * qw1[0]; q[5] *= rq * qw1[1]; q[6] *= rq * qw1[2]; q[7] *= rq * qw1[3];
        k[0] *= rk * kw0[0]; k[1] *= rk * kw0[1]; k[2] *= rk * kw0[2]; k[3] *= rk * kw0[3]; k[4] *= rk * kw1[0]; k[5] *= rk * kw1[1]; k[6] *= rk * kw1[2]; k[7] *= rk * kw1[3];
#pragma unroll
        for (int e = 0; e < 8; ++e) ksum[e] += k[e];
        u32x4 qo, ko;
        qo.x = cvt_pk_bf16(q[0], q[1]); qo.y = cvt_pk_bf16(q[2], q[3]); qo.z = cvt_pk_bf16(q[4], q[5]); qo.w = cvt_pk_bf16(q[6], q[7]);
        ko.x = cvt_pk_bf16(k[0], k[1]); ko.y = cvt_pk_bf16(k[2], k[3]); ko.z = cvt_pk_bf16(k[4], k[5]); ko.w = cvt_pk_bf16(k[6], k[7]);
        *(u32x4*)(mq + off) = qo; *(u32x4*)(mk + off) = ko;
    }
    }
#pragma unroll
    for (int e = 0; e < 8; ++e) { ksum[e] += __shfl_xor(ksum[e], 16); ksum[e] += __shfl_xor(ksum[e], 32); }
    if (lane < 16) {
#pragma unroll
        for (int e = 0; e < 8; ++e) red[wave * 128 + 8 * lane + e] = ksum[e];
    }
    __syncthreads();
    if (tid < 128) { float s = 0.f;
#pragma unroll
        for (int w = 0; w < 8; ++w) s += red[w * 128 + tid];
        ((float*)((unsigned char*)p.out + DO_KMEAN))[(size_t)item * 128 + tid] = s * (1.f / 256.f); }
    bf16_t* vT = (bf16_t*)(p.ws + WS_T2) + (size_t)item * 32768;
#pragma unroll 2
    for (int it = 0; it < 8; ++it) {
        const int d = (tid >> 5) + 16 * it, pg = tid & 31, kg = pg >> 2, g4 = pg & 3;
        unsigned short e[8];
#pragma unroll
        for (int j = 0; j < 8; ++j) { const int key = 32 * kg + 16 * (j >> 2) + 4 * g4 + (j & 3); e[j] = vl[key * 128 + 8 * ((d >> 3) ^ (((key >> 5) + 2 * ((key >> 2) & 3)) & 7)) + (d & 7)]; }
        u32x4 o; o.x = e[0] | ((unsigned)e[1] << 16); o.y = e[2] | ((unsigned)e[3] << 16); o.z = e[4] | ((unsigned)e[5] << 16); o.w = e[6] | ((unsigned)e[7] << 16);
        *(u32x4*)(vT + d * 256 + pg * 8) = o;
    }
    __syncthreads();
}

constexpr int RS = 132;
constexpr int GP_QB = 0, GP_KB = 17408, GP_RK = 34816, GP_RV = 68608, GP_KDT = 102400, GP_LM = 120832, GP_AML = 137216, GP_GC = 146432, GP_BETA = 146688, GP_CW = 146944;
static_assert(GP_CW + 6144 <= LDS_BYTES, "gdn prep LDS");
#define LBAR() asm volatile("s_waitcnt lgkmcnt(0)\n\ts_barrier" ::: "memory")
template <int J> __device__ __forceinline__ void macb(float& s, int Lq, float x) { asm volatile("v_fmac_f32_dpp %0, %1, %2 row_newbcast:%3 row_mask:0xf bank_mask:0xf" : "+v"(s) : "v"(Lq), "v"(x), "n"(J)); }
template <int J, int N, int OFF> struct MacDpp { static __device__ __forceinline__ void run(int Lq, const float (&xs)[64], float& s0, float& s1) {
    if constexpr (J < N) { if constexpr (J & 1) macb<J>(s1, Lq, xs[OFF + J]); else macb<J>(s0, Lq, xs[OFF + J]); MacDpp<J + 1, N, OFF>::run(Lq, xs, s0, s1); } } };
template <int I> struct SolveRow { static __device__ __forceinline__ void run(const float* Lneg, const float* base, float (&xs)[64], const int (&Lc)[4], float rc, int lane15) {
    int Ln[4] = {0, 0, 0, 0}; float rn = 0.f;
    if constexpr (I < 63) { constexpr int NQ = (I + 1 + 15) / 16;
        if constexpr (NQ > 0) Ln[0] = __float_as_int(Lneg[(I + 1) * 64 + lane15]);
        if constexpr (NQ > 1) Ln[1] = __float_as_int(Lneg[(I + 1) * 64 + 16 + lane15]);
        if constexpr (NQ > 2) Ln[2] = __float_as_int(Lneg[(I + 1) * 64 + 32 + lane15]);
        if constexpr (NQ > 3) Ln[3] = __float_as_int(Lneg[(I + 1) * 64 + 48 + lane15]);
        rn = base[(I + 1) * RS]; }
    float s0 = rc, s1 = 0.f;
    MacDpp<0, (I > 16 ? 16 : I), 0>::run(Lc[0], xs, s0, s1);
    if constexpr (I > 16) MacDpp<0, (I > 32 ? 16 : I - 16), 16>::run(Lc[1], xs, s0, s1);
    if constexpr (I > 32) MacDpp<0, (I > 48 ? 16 : I - 32), 32>::run(Lc[2], xs, s0, s1);
    if constexpr (I > 48) MacDpp<0, I - 48, 48>::run(Lc[3], xs, s0, s1);
    xs[I] = s0 + s1;
    __builtin_amdgcn_sched_barrier(0);
    if constexpr (I < 63) SolveRow<I + 1>::run(Lneg, base, xs, Ln, rn, lane15);
} };
#define GP_ISSUE(raw_, gpre_, bpre_, item_) do { const int c_ = (item_) & 127, bh_ = (item_) >> 7, h_ = bh_ & 7, b_ = bh_ >> 3, t0_ = c_ * 64; \
    const bf16_t* pj_ = (const bf16_t*)(p.ws + WS_PROJ); const int ch_ = h_ * 128 + 8 * ((int)threadIdx.x & 15); \
    _Pragma("unroll") for (int sec = 0; sec < 3; ++sec) _Pragma("unroll") for (int ps = 0; ps < 2; ++ps) _Pragma("unroll") for (int j = 0; j < 4; ++j) { \
        const int tt = t0_ + 32 * ps + ((int)threadIdx.x >> 4) - 3 + j; raw_[sec][ps][j] = (u32x4){0u, 0u, 0u, 0u}; \
        if (tt >= 0) raw_[sec][ps][j] = *(const u32x4*)(pj_ + (size_t)sec * SEC + ((size_t)b_ * NT + tt) * 1024 + ch_); } \
    if (threadIdx.x < 64) { gpre_ = ((const float*)((const unsigned char*)p.out + DO_G))[(size_t)bh_ * NT + t0_ + threadIdx.x]; \
        bpre_ = ((const float*)((const unsigned char*)p.out + DO_BETA))[(size_t)bh_ * NT + t0_ + threadIdx.x]; } } while (0)
__device__ __forceinline__ void gdn_prep_item(const Params& p, unsigned char* lds, int item, u32x4 (&raw)[3][2][4], float& gpre, float& bpre, int next_item) {
    const int tid = threadIdx.x, lane = tid & 63, wave = tid >> 6;
    const int c = item & 127, bh = item >> 7, h = bh & 7, b = bh >> 3;
    const int t0 = c * 64;
    unsigned char* dob = (unsigned char*)p.out;
    unsigned char* rec = dob + (size_t)item * REC_BYTES;
    const bf16_t* proj = (const bf16_t*)(p.ws + WS_PROJ);
    bf16_t* qb = (bf16_t*)(lds + GP_QB); bf16_t* kb = (bf16_t*)(lds + GP_KB);
    float* rhsK = (float*)(lds + GP_RK); float* rhsV = (float*)(lds + GP_RV);
    bf16_t* kdT = (bf16_t*)(lds + GP_KDT); float* Lm = (float*)(lds + GP_LM); bf16_t* Aml = (bf16_t*)(lds + GP_AML);
    float* gcs = (float*)(lds + GP_GC); float* bets = (float*)(lds + GP_BETA);
    const int grp = tid & 15, a16 = grp >> 1, bb = grp & 1;
    if (wave == 0) {
        float g = gpre; const float be = bpre;
#pragma unroll
        for (int o = 1; o < 64; o <<= 1) { const float t = __shfl_up(g, o); if (lane >= o) g += t; }
        gcs[lane] = g; bets[lane] = be;
        if (lane == 63) ((float*)(dob + DO_GL))[item] = __expf(g);
    }
    LBAR();
    const float glast = gcs[63];
    {
        const float* cwl = (const float*)(lds + GP_CW);
#pragma unroll
        for (int sec = 0; sec < 3; ++sec) {
#pragma unroll
            for (int ps = 0; ps < 2; ++ps) {
                const int i = 32 * ps + (tid >> 4);
                float y[8];
#pragma unroll
                for (int e = 0; e < 8; ++e) y[e] = 0.f;
#pragma unroll
                for (int j = 0; j < 4; ++j) { const u32x4 w = raw[sec][ps][j];
                    const f32x4 c0 = *(const f32x4*)(cwl + (j * 3 + sec) * 128 + 8 * grp), c1 = *(const f32x4*)(cwl + (j * 3 + sec) * 128 + 8 * grp + 4);
                    y[0] += c0[0] * bflo(w.x); y[1] += c0[1] * bfhi(w.x); y[2] += c0[2] * bflo(w.y); y[3] += c0[3] * bfhi(w.y);
                    y[4] += c1[0] * bflo(w.z); y[5] += c1[1] * bfhi(w.z); y[6] += c1[2] * bflo(w.w); y[7] += c1[3] * bfhi(w.w); }
#pragma unroll
                for (int e = 0; e < 8; ++e) y[e] = y[e] * __builtin_amdgcn_rcpf(1.f + __expf(-y[e]));
                const float gci = gcs[i], bi = bets[i];
                if (sec < 2) {
                    float ss = 0.f;
#pragma unroll
                    for (int e = 0; e < 8; ++e) ss += y[e] * y[e];
#pragma unroll
                    for (int o = 1; o < 16; o <<= 1) ss += __shfl_xor(ss, o);
                    const float rn = rsqrtf(ss + RMS_EPS);
                    if (sec == 0) {
                        const float sc = rn * 0.08838834764831845f, eg = __expf(gci);
#pragma unroll
                        for (int e = 0; e < 8; ++e) y[e] *= sc;
                        u32x4 w; w.x = cvt_pk_bf16(y[0], y[1]); w.y = cvt_pk_bf16(y[2], y[3]); w.z = cvt_pk_bf16(y[4], y[5]); w.w = cvt_pk_bf16(y[6], y[7]);
                        *(u32x4*)(qb + i * 136 + 8 * grp) = w;
                        u32x2 lo, hi; lo.x = cvt_pk_bf16(y[0] * eg, y[1] * eg); lo.y = cvt_pk_bf16(y[2] * eg, y[3] * eg); hi.x = cvt_pk_bf16(y[4] * eg, y[5] * eg); hi.y = cvt_pk_bf16(y[6] * eg, y[7] * eg);
                        bf16_t* qd = (bf16_t*)(rec + 16384) + i * 128 + 16 * a16;
                        *(u32x2*)(qd + 4 * bb) = lo; *(u32x2*)(qd + 8 + 4 * bb) = hi;
                    } else {
#pragma unroll
                        for (int e = 0; e < 8; ++e) y[e] *= rn;
                        u32x4 w; w.x = cvt_pk_bf16(y[0], y[1]); w.y = cvt_pk_bf16(y[2], y[3]); w.z = cvt_pk_bf16(y[4], y[5]); w.w = cvt_pk_bf16(y[6], y[7]);
                        *(u32x4*)(kb + i * 136 + 8 * grp) = w;
                        const float f1 = bi * __expf(gci), f2 = __expf(glast - gci);
                        f32x4 r0 = {y[0] * f1, y[1] * f1, y[2] * f1, y[3] * f1}, r1 = {y[4] * f1, y[5] * f1, y[6] * f1, y[7] * f1};
                        *(f32x4*)(rhsK + i * RS + 8 * grp) = r0; *(f32x4*)(rhsK + i * RS + 8 * grp + 4) = r1;
                        const int pos = (i & ~15) + perm16(i & 15);
#pragma unroll
                        for (int e = 0; e < 8; ++e) kdT[(8 * grp + e) * 72 + (pos ^ ((grp & 7) << 3))] = (bf16_t)f2bf(y[e] * f2);
                    }
                } else {
                    f32x4 r0 = {y[0] * bi, y[1] * bi, y[2] * bi, y[3] * bi}, r1 = {y[4] * bi, y[5] * bi, y[6] * bi, y[7] * bi};
                    *(f32x4*)(rhsV + i * RS + 8 * grp) = r0; *(f32x4*)(rhsV + i * RS + 8 * grp + 4) = r1;
                }
            }
        }
    }
    LBAR();
    {
        const int mat = wave >> 2, ti = (wave >> 1) & 1, tj = wave & 1, r32 = lane & 31, g = lane >> 5;
        f32x16 acc;
#pragma unroll
        for (int r = 0; r < 16; ++r) acc[r] = 0.f;
        if (tj <= ti && !(p.flags & 32)) {
            const bf16_t* Xa = (mat ? qb : kb) + (32 * ti + r32) * 136 + 8 * g;
            const bf16_t* Xb = kb + (32 * tj + r32) * 136 + 8 * g;
#pragma unroll
            for (int s = 0; s < 8; ++s) { const bf16x8 a = *(const bf16x8*)(Xa + 16 * s), bq = *(const bf16x8*)(Xb + 16 * s); acc = __builtin_amdgcn_mfma_f32_32x32x16_bf16(a, bq, acc, 0, 0, 0); }
        }
        const int j = 32 * tj + r32; const float gcj = gcs[j];
        const int posj = (j & ~15) + perm16(j & 15);
        int ib = 32 * ti + 4 * g; asm volatile("" : "+v"(ib));
        const float* gci_p = gcs + ib; const float* bti_p = bets + ib;
#pragma unroll
        for (int r = 0; r < 16; ++r) { const int io = (r & 3) + 8 * (r >> 2); const int i = ib + io;
            const float gi = gci_p[io], bt = bti_p[io];
            const float dec = __expf(fminf(gi - gcj, 0.f));
            const float lv = (i > j) ? acc[r] * bt * dec : 0.f, av = (i >= j) ? acc[r] * dec : 0.f;
            if (mat == 0) Lm[i * 64 + j] = -lv;
            else Aml[i * 72 + posj] = (bf16_t)f2bf(av); }
    }
    LBAR();
    if (next_item >= 0) GP_ISSUE(raw, gpre, bpre, next_item);
    if (tid < 256 && !(p.flags & 16)) {
        float* base = (tid < 128) ? (rhsK + tid) : (rhsV + (tid - 128));
        float xs[64];
#pragma unroll
        for (int i = 0; i < 64; ++i) xs[i] = 0.f;
        { const int L0[4] = {0, 0, 0, 0}; SolveRow<0>::run(Lm, base, xs, L0, base[0], lane & 15); }
#pragma unroll
        for (int i = 0; i < 64; ++i) base[i * RS] = xs[i];
    } else if (tid >= 256) {
        const int t2 = tid - 256;
#pragma unroll
        for (int k = 0; k < 4; ++k) { const int pc = t2 + 256 * k, row = pc >> 3, cc = pc & 7;
            *(u32x4*)(rec + 32768 + row * 128 + cc * 16) = *(const u32x4*)((const unsigned char*)kdT + row * 144 + ((cc ^ ((row >> 3) & 7)) * 16)); }
#pragma unroll
        for (int k = 0; k < 2; ++k) { const int pc = t2 + 256 * k, row = pc >> 3, cc = pc & 7;
            *(u32x4*)(rec + 49152 + row * 128 + cc * 16) = *(const u32x4*)((const unsigned char*)Aml + row * 144 + cc * 16); }
    }
    LBAR();
    {
        const int i = tid >> 3, a = tid & 7;
        float v[16];
#pragma unroll
        for (int q4 = 0; q4 < 4; ++q4) { const f32x4 t = *(const f32x4*)(rhsK + i * RS + 16 * a + 4 * q4); v[4 * q4] = -t[0]; v[4 * q4 + 1] = -t[1]; v[4 * q4 + 2] = -t[2]; v[4 * q4 + 3] = -t[3]; }
        u32x4 o0, o1;
        o0.x = cvt_pk_bf16(v[0], v[1]); o0.y = cvt_pk_bf16(v[2], v[3]); o0.z = cvt_pk_bf16(v[8], v[9]); o0.w = cvt_pk_bf16(v[10], v[11]);
        o1.x = cvt_pk_bf16(v[4], v[5]); o1.y = cvt_pk_bf16(v[6], v[7]); o1.z = cvt_pk_bf16(v[12], v[13]); o1.w = cvt_pk_bf16(v[14], v[15]);
        *(u32x4*)(rec + i * 256 + a * 32) = o0; *(u32x4*)(rec + i * 256 + a * 32 + 16) = o1;
    }
    {
        const int sl = tid >> 7, mt = (tid >> 6) & 1, g = lane >> 5, cn = lane & 31;
        float v[16];
#pragma unroll
        for (int r = 0; r < 16; ++r) v[r] = rhsV[(32 * mt + (r & 3) + 8 * (r >> 2) + 4 * g) * RS + 32 * sl + cn];
        u32x4 o0, o1;
        o0.x = cvt_pk_bf16(v[0], v[1]); o0.y = cvt_pk_bf16(v[2], v[3]); o0.z = cvt_pk_bf16(v[4], v[5]); o0.w = cvt_pk_bf16(v[6], v[7]);
        o1.x = cvt_pk_bf16(v[8], v[9]); o1.y = cvt_pk_bf16(v[10], v[11]); o1.z = cvt_pk_bf16(v[12], v[13]); o1.w = cvt_pk_bf16(v[14], v[15]);
        unsigned char* ub = p.ws + WS_T0 + (size_t)item * 16384 + (size_t)(((sl * 2 + mt) * 64 + lane) * 32);
        *(u32x4*)ub = o0; *(u32x4*)(ub + 16) = o1;
    }
    LBAR();
}
__device__ __forceinline__ void route_item(const Params& p, float* sc  , int witem, int lane) {
    const int qt = witem & 255, bh = witem >> 8, h = bh & 7, b = bh >> 3, qblk = qt >> 3;
    unsigned* sel = (unsigned*)((unsigned char*)p.out + DO_SEL) + (size_t)bh * NT + 32 * qt;
    if (qblk == 0) { if (lane < 32) sel[lane] = 0xFFFFFFu; return; }
    const int r32 = lane & 31, g = lane >> 5;
    const bf16_t* qrow = (const bf16_t*)(p.ws + WS_PROJ) + 4 * SEC + ((size_t)b * NT + 32 * qt + r32) * 1024 + h * 128 + 8 * g;
    const float* km = (const float*)((unsigned char*)p.out + DO_KMEAN) + ((size_t)bh * 32 + r32) * 128 + 8 * g;
    f32x16 acc;
#pragma unroll
    for (int r = 0; r < 16; ++r) acc[r] = 0.f;
#pragma unroll
    for (int s = 0; s < 8; ++s) {
        const bf16x8 a = *(const bf16x8*)(qrow + 16 * s);
        const f32x4 k0 = *(const f32x4*)(km + 16 * s), k1 = *(const f32x4*)(km + 16 * s + 4);
        float kf[8] = {k0[0], k0[1], k0[2], k0[3], k1[0], k1[1], k1[2], k1[3]};
        unsigned hi[8], lo[8];
#pragma unroll
        for (int e = 0; e < 8; ++e) { hi[e] = f2bf(kf[e]); lo[e] = f2bf(kf[e] - __uint_as_float(hi[e] << 16)); }
        u32x4 hw, lw;
        hw.x = hi[0] | (hi[1] << 16); hw.y = hi[2] | (hi[3] << 16); hw.z = hi[4] | (hi[5] << 16); hw.w = hi[6] | (hi[7] << 16);
        lw.x = lo[0] | (lo[1] << 16); lw.y = lo[2] | (lo[3] << 16); lw.z = lo[4] | (lo[5] << 16); lw.w = lo[6] | (lo[7] << 16);
        acc = __builtin_amdgcn_mfma_f32_32x32x16_bf16(a, __builtin_bit_cast(bf16x8, hw), acc, 0, 0, 0);
        acc = __builtin_amdgcn_mfma_f32_32x32x16_bf16(a, __builtin_bit_cast(bf16x8, lw), acc, 0, 0, 0);
    }
#pragma unroll
    for (int r = 0; r < 16; ++r) sc[((r & 3) + 8 * (r >> 2) + 4 * g) * 33 + r32] = acc[r];
    LDS_WAIT();
    if (lane < 32) {
        float b0 = -3e38f, b1 = -3e38f, b2 = -3e38f; unsigned i0 = 255, i1 = 255, i2 = 255;
        for (int n = 0; n < qblk; ++n) { const float v = sc[lane * 33 + n];
            if (v > b0) { b2 = b1; i2 = i1; b1 = b0; i1 = i0; b0 = v; i0 = n; }
            else if (v > b1) { b2 = b1; i2 = i1; b1 = v; i1 = n; }
            else if (v > b2) { b2 = v; i2 = n; } }
        sel[lane] = i0 | (i1 << 8) | (i2 << 16);
    }
    LDS_WAIT();
}

constexpr int SC_W = 0, SC_Q = 17408, SC_K = 34816, SC_A = 53248, SC_BUF = 62464;
__device__ __forceinline__ void scan_bh(const Params& p, unsigned char* lds, int bh) {
    const int tid = threadIdx.x, lane = tid & 63, wave = tid >> 6;
    const int h = bh & 7, b = bh >> 3, r32 = lane & 31, g = lane >> 5;
    unsigned char* dob = (unsigned char*)p.out;
    const unsigned char* recb = dob + (size_t)bh * 128 * REC_BYTES;
    const unsigned char* ub = p.ws + WS_T0 + (size_t)bh * 128 * 16384;
    const float* glp = (const float*)(dob + DO_GL) + bh * 128;
    bf16_t* ob = (bf16_t*)(p.ws + WS_T1);
    const bool loader = wave >= 4;
    const int lt = tid - 256;
    u32x4 st[14];
#define SC_ISSUE(c_) do { const unsigned char* rp = recb + (size_t)(c_) * REC_BYTES + lt * 16; \
        _Pragma("unroll") for (int k = 0; k < 14; ++k) st[k] = *(const u32x4*)(rp + 4096 * k); } while (0)
#define SC_COMMIT(buf_) do { unsigned char* Lw = lds + (buf_) * SC_BUF; \
        _Pragma("unroll") for (int k = 0; k < 14; ++k) { const int off = lt * 16 + 4096 * k; int dst; \
            if (k < 4) { const int o = off; dst = SC_W + (o >> 8) * 272 + (o & 255); } \
            else if (k < 8) { const int o = off - 16384; dst = SC_Q + (o >> 8) * 272 + (o & 255); } \
            else if (k < 12) { const int o = off - 32768; dst = SC_K + (o >> 7) * 144 + (o & 127); } \
            else { const int o = off - 49152; dst = SC_A + (o >> 7) * 144 + (o & 127); } \
            *(u32x4*)(Lw + dst) = st[k]; } } while (0)
    f32x16 S[4];
#pragma unroll
    for (int kt = 0; kt < 4; ++kt)
#pragma unroll
        for (int r = 0; r < 16; ++r) S[kt][r] = 0.f;
    u32x4 un[4];
    float gln = 1.f;
    const int sl = wave;
    if (loader) { SC_ISSUE(0); SC_COMMIT(0); SC_ISSUE(1); }
    else {
        const unsigned char* up = ub + (size_t)((sl * 2) * 64 + lane) * 32;
        un[0] = *(const u32x4*)up; un[1] = *(const u32x4*)(up + 16); un[2] = *(const u32x4*)(up + 2048); un[3] = *(const u32x4*)(up + 2048 + 16);
        gln = glp[0];
    }
    __syncthreads();
    for (int c = 0; c < 128; ++c) {
        if (loader) {
            if (c + 1 < 128) SC_COMMIT((c + 1) & 1);
            if (c + 2 < 128) SC_ISSUE(c + 2);
        } else {
            const unsigned char* L = lds + (c & 1) * SC_BUF;
            u32x4 uc[4] = {un[0], un[1], un[2], un[3]}; const float gl = gln;
            if (c + 1 < 128) { const unsigned char* up = ub + (size_t)(c + 1) * 16384 + (size_t)((sl * 2) * 64 + lane) * 32;
                un[0] = *(const u32x4*)up; un[1] = *(const u32x4*)(up + 16); un[2] = *(const u32x4*)(up + 2048); un[3] = *(const u32x4*)(up + 2048 + 16);
                gln = glp[c + 1]; }
            bf16x8 Sb[8];
#pragma unroll
            for (int s = 0; s < 8; ++s) { const int kt = s >> 1, o = 8 * (s & 1); u32x4 w;
                w.x = cvt_pk_bf16(S[kt][o], S[kt][o + 1]); w.y = cvt_pk_bf16(S[kt][o + 2], S[kt][o + 3]); w.z = cvt_pk_bf16(S[kt][o + 4], S[kt][o + 5]); w.w = cvt_pk_bf16(S[kt][o + 6], S[kt][o + 7]);
                Sb[s] = __builtin_bit_cast(bf16x8, w); }
            f32x16 vn[2];
#pragma unroll
            for (int mt = 0; mt < 2; ++mt) {
#pragma unroll
                for (int r = 0; r < 16; ++r) vn[mt][r] = 0.f;
                const unsigned char* wa = L + SC_W + (32 * mt + r32) * 272 + 16 * g;
#pragma unroll
                for (int s = 0; s < 8; ++s) { const bf16x8 a = *(const bf16x8*)(wa + 32 * s); vn[mt] = __builtin_amdgcn_mfma_f32_32x32x16_bf16(a, Sb[s], vn[mt], 0, 0, 0); }
                const u32x4 u0 = uc[2 * mt], u1 = uc[2 * mt + 1];
                vn[mt][0] += bflo(u0.x); vn[mt][1] += bfhi(u0.x); vn[mt][2] += bflo(u0.y); vn[mt][3] += bfhi(u0.y); vn[mt][4] += bflo(u0.z); vn[mt][5] += bfhi(u0.z); vn[mt][6] += bflo(u0.w); vn[mt][7] += bfhi(u0.w);
                vn[mt][8] += bflo(u1.x); vn[mt][9] += bfhi(u1.x); vn[mt][10] += bflo(u1.y); vn[mt][11] += bfhi(u1.y); vn[mt][12] += bflo(u1.z); vn[mt][13] += bfhi(u1.z); vn[mt][14] += bflo(u1.w); vn[mt][15] += bfhi(u1.w);
            }
            bf16x8 Vb[4];
#pragma unroll
            for (int s = 0; s < 4; ++s) { const int mt = s >> 1, oo = 8 * (s & 1); u32x4 w;
                w.x = cvt_pk_bf16(vn[mt][oo], vn[mt][oo + 1]); w.y = cvt_pk_bf16(vn[mt][oo + 2], vn[mt][oo + 3]); w.z = cvt_pk_bf16(vn[mt][oo + 4], vn[mt][oo + 5]); w.w = cvt_pk_bf16(vn[mt][oo + 6], vn[mt][oo + 7]);
                Vb[s] = __builtin_bit_cast(bf16x8, w); }
#pragma unroll
            for (int mt = 0; mt < 2; ++mt) {
                f32x16 o;
#pragma unroll
                for (int r = 0; r < 16; ++r) o[r] = 0.f;
                const unsigned char* qa = L + SC_Q + (32 * mt + r32) * 272 + 16 * g;
#pragma unroll
                for (int s = 0; s < 8; ++s) { const bf16x8 a = *(const bf16x8*)(qa + 32 * s); o = __builtin_amdgcn_mfma_f32_32x32x16_bf16(a, Sb[s], o, 0, 0, 0); }
                const unsigned char* aa = L + SC_A + (32 * mt + r32) * 144 + 16 * g;
#pragma unroll
                for (int s = 0; s < 4; ++s) if (s <= 2 * mt + 1) { const bf16x8 a = *(const bf16x8*)(aa + 32 * s); o = __builtin_amdgcn_mfma_f32_32x32x16_bf16(a, Vb[s], o, 0, 0, 0); }
#pragma unroll
                for (int r = 0; r < 16; ++r) { const int tok = 64 * c + 32 * mt + (r & 3) + 8 * (r >> 2) + 4 * g;
                    ob[((size_t)b * NT + tok) * 1024 + h * 128 + 32 * sl + r32] = (bf16_t)f2bf(o[r]); }
                __builtin_amdgcn_sched_barrier(0);
            }
#pragma unroll
            for (int kt = 0; kt < 4; ++kt) {
#pragma unroll
                for (int r = 0; r < 16; ++r) S[kt][r] *= gl;
                const unsigned char* ka = L + SC_K + (32 * kt + r32) * 144 + 16 * g;
#pragma unroll
                for (int s = 0; s < 4; ++s) { const bf16x8 a = *(const bf16x8*)(ka + 32 * s); S[kt] = __builtin_amdgcn_mfma_f32_32x32x16_bf16(a, Vb[s], S[kt], 0, 0, 0); }
            }
        }
        __syncthreads();
    }
}
constexpr int AT_K = 0, AT_V = 69632, AT_Q = 137216, AT_B = 141312, AT_MISC = 149504;
static_assert(AT_MISC + 64 <= LDS_BYTES, "attn LDS");
__device__ __forceinline__ void attn_item(const Params& p, unsigned char* lds, int item) {
    const int tid = threadIdx.x, lane = tid & 63, wave = tid >> 6;
    const int n = item >> 5, bh = item & 31, h = bh & 7, b = bh >> 3;
    unsigned char* dob = (unsigned char*)p.out;
    const bf16_t* proj = (const bf16_t*)(p.ws + WS_PROJ);
    const bf16_t* mq = proj + 4 * SEC; const bf16_t* mk = proj + 5 * SEC;
    {
        const unsigned char* ksrc = (const unsigned char*)(mk + ((size_t)b * NT + n * 256) * 1024 + h * 128);
        const unsigned char* vsrc = p.ws + WS_T2 + (size_t)((bh * 32) + n) * 65536;
        int tido = tid; asm volatile("" : "+v"(tido));
#pragma unroll
        for (int k = 0; k < 8; ++k) { const int pc = tido + 512 * k, row = pc >> 4, cc = pc & 15;
            *(u32x4*)(lds + AT_K + row * 272 + cc * 16) = *(const u32x4*)(ksrc + (size_t)row * 2048 + cc * 16); }
#pragma unroll
        for (int k = 0; k < 8; ++k) { const int pc = tido + 512 * k, row = pc >> 5, cc = pc & 31;
            *(u32x4*)(lds + AT_V + row * 528 + cc * 16) = *(const u32x4*)(vsrc + (size_t)pc * 16); }
        *(u32x4*)(lds + AT_B + tido * 16) = *(const u32x4*)((const unsigned char*)dob + DO_BIAS + (size_t)h * 32768 + tido * 16);
    }
    __syncthreads();
    volatile unsigned* queue = (volatile unsigned*)(lds + AT_Q) + wave * 128;
    const unsigned* sel = (const unsigned*)(dob + DO_SEL) + (size_t)bh * NT;
    float* ML = (float*)(dob + DO_ML);
    bf16_t* projw = (bf16_t*)(p.ws + WS_PROJ);
    const int qi = lane & 15, g4 = lane >> 4;
    const int nchunks = (NT - (n + 1) * 256) / 64;
    const float* biasL = (const float*)(lds + AT_B);
    int own_left = 1, cc = wave, count = 0;
    unsigned svb0, svb1, svb2, svb3; int svn, ccl = wave;
#define AT_REFILL() do { const unsigned so = (unsigned)((n + 1) * 256 + lane + 64 * ccl);        \
        svb0 = (ccl < nchunks) ? sel[so] : 0xFFFFFFFFu; svb1 = (ccl + 8 < nchunks) ? sel[so + 512u] : 0xFFFFFFFFu; \
        svb2 = (ccl + 16 < nchunks) ? sel[so + 1024u] : 0xFFFFFFFFu; svb3 = (ccl + 24 < nchunks) ? sel[so + 1536u] : 0xFFFFFFFFu; ccl += 32; svn = 4; } while (0)
    AT_REFILL();
#define AT_NEXT(have_, tqA_, slA_, vA_, tqB_, slB_, vB_, nkt_) do { have_ = true; tqA_ = 0; tqB_ = 0; slA_ = 3; slB_ = 3; nkt_ = 16; vA_ = false; vB_ = false; \
        if (own_left > 0) { own_left = 0; tqA_ = n * 256 + 32 * wave + qi; tqB_ = tqA_ + 16; vA_ = true; vB_ = true; nkt_ = 2 * wave + 2; } \
        else { \
            while (count < 32 && cc < nchunks) { \
                if (svn == 0) AT_REFILL(); \
                const int t = (n + 1) * 256 + 64 * cc + lane; cc += 8; \
                const unsigned sv = svb0; svb0 = svb1; svb1 = svb2; svb2 = svb3; --svn; const int nv = min(3, t >> 8); int sl = -1; \
                if ((int)(sv & 255u) == n && nv > 0) sl = 0; else if ((int)((sv >> 8) & 255u) == n && nv > 1) sl = 1; else if ((int)((sv >> 16) & 255u) == n && nv > 2) sl = 2; \
                const unsigned long long mask = __ballot(sl >= 0); \
                if (sl >= 0) { const int rank = __popcll(mask & ((1ull << lane) - 1ull)); queue[count + rank] = (unsigned)t | ((unsigned)sl << 16); } \
                count += __popcll(mask); } \
            if (count == 0) have_ = false; \
            else { LDS_WAIT(); const int take = count < 32 ? count : 32; \
                const unsigned eA = queue[qi], eB = queue[16 + qi]; vA_ = qi < take; vB_ = 16 + qi < take; \
                tqA_ = (int)(eA & 0xffffu); slA_ = (int)(eA >> 16); tqB_ = (int)(eB & 0xffffu); slB_ = (int)(eB >> 16); \
                if (!vA_) { tqA_ = 0; slA_ = 0; } if (!vB_) { tqB_ = 0; slB_ = 0; } \
                const unsigned mv = (lane + 32 < count) ? queue[lane + 32] : 0u; \
                LDS_WAIT(); \
                if (lane + 32 < count) queue[lane] = mv; \
                LDS_WAIT(); \
                count -= take; } \
            if (svn == 0 && cc < nchunks) AT_REFILL(); } } while (0)
#define AT_LOADQ(bq_, tq_, valid_) do { const bf16_t* qp = mq + ((size_t)b * NT + tq_) * 1024 + h * 128 + 8 * g4; \
        _Pragma("unroll") for (int s = 0; s < 4; ++s) { u32x4 w = {0u, 0u, 0u, 0u}; if (valid_) w = *(const u32x4*)(qp + 32 * s); bq_[s] = __builtin_bit_cast(bf16x8, w); } } while (0)
#define AT_SOFT(sv_, tq_, valid_, mode_, m_, l_, ot_, pb_) do { \
        float cm = -1e30f; \
        if (mode_ == 2) { _Pragma("unroll") for (int k4 = 0; k4 < 2; ++k4) cm = fmaxf(fmaxf(cm, fmaxf(sv_[k4][0], sv_[k4][1])), fmaxf(sv_[k4][2], sv_[k4][3])); } \
        else if (mode_ == 1) { int d0 = tq_ - n * 256 - 4 * g4 - 32 * ch; asm volatile("" : "+v"(d0));        \
            _Pragma("unroll") for (int k4 = 0; k4 < 2; ++k4) _Pragma("unroll") for (int e = 0; e < 4; ++e) { const unsigned dist = (unsigned)(d0 - (16 * k4 + e)); \
                const float sx = sv_[k4][e] + biasL[min(dist, 2047u)]; sv_[k4][e] = sx; cm = fmaxf(cm, sx); } } \
        else { int d0 = tq_ - n * 256 - 4 * g4 - 32 * ch; asm volatile("" : "+v"(d0)); \
            _Pragma("unroll") for (int k4 = 0; k4 < 2; ++k4) _Pragma("unroll") for (int e = 0; e < 4; ++e) { const int dist = d0 - (16 * k4 + e); \
                const bool ok = valid_ && dist >= 0 && (2 * ch + k4 < nkt); \
                float sx = sv_[k4][e] + biasL[ok ? min(dist, 2047) : 0]; sx = ok ? sx : -1e30f; sv_[k4][e] = sx; cm = fmaxf(cm, sx); } } \
        cm = fmaxf(cm, __shfl_xor(cm, 16)); cm = fmaxf(cm, __shfl_xor(cm, 32)); \
        const float mn = fmaxf(m_, cm); \
        if (__any(mn != m_)) { const float al = __builtin_amdgcn_exp2f(m_ - mn); l_ *= al;        \
            _Pragma("unroll") for (int dt = 0; dt < 8; ++dt) ot_[dt] = ot_[dt] * al; } \
        m_ = mn; \
        _Pragma("unroll") for (int k4 = 0; k4 < 2; ++k4) _Pragma("unroll") for (int e = 0; e < 4; ++e) { const float pe = __builtin_amdgcn_exp2f(sv_[k4][e] - mn); sv_[k4][e] = pe; l_ += pe; } \
        { u32x4 w; w.x = cvt_pk_bf16(sv_[0][0], sv_[0][1]); w.y = cvt_pk_bf16(sv_[0][2], sv_[0][3]); \
            w.z = cvt_pk_bf16(sv_[1][0], sv_[1][1]); w.w = cvt_pk_bf16(sv_[1][2], sv_[1][3]); pb_ = __builtin_bit_cast(bf16x8, w); } } while (0)
#define AT_STORE(ot_, m_, l_, tq_, slot_, valid_, cb_) do { float lt = l_; lt += __shfl_xor(lt, 16); lt += __shfl_xor(lt, 32); \
        if (valid_) { const float inv = 1.f / lt; const int osec = (slot_ == 3) ? 6 : slot_; \
            bf16_t* op = projw + (size_t)osec * SEC + ((size_t)b * NT + tq_) * 1024 + h * 128 + 4 * g4; \
            _Pragma("unroll") for (int dt = 0; dt < 8; ++dt) { u32x2 w; w.x = cvt_pk_bf16(ot_[dt][0] * inv, ot_[dt][1] * inv); w.y = cvt_pk_bf16(ot_[dt][2] * inv, ot_[dt][3] * inv); *(u32x2*)(op + 16 * dt) = w; } \
            if (g4 == 0) { float* mlp = ML + ((size_t)slot_ * 32 * NT + (size_t)bh * NT + tq_) * 2; mlp[0] = m_ + cb_; mlp[1] = lt; } } } while (0)
    own_left = 1;
    bool have, ownP = true; int tqA, tqB, slA, slB, nkt; bool vA, vB; bf16x8 bqA[4], bqB[4];
    AT_NEXT(have, tqA, slA, vA, tqB, slB, vB, nkt);
    if (have) { AT_LOADQ(bqA, tqA, vA); AT_LOADQ(bqB, tqB, vB); }
    while (have) {
        bool haveN; int tqAn, tqBn, slAn, slBn, nktN; bool vAn, vBn; bf16x8 bqAn[4], bqBn[4];
        AT_NEXT(haveN, tqAn, slAn, vAn, tqBn, slBn, vBn, nktN);
        if (haveN) { AT_LOADQ(bqAn, tqAn, vAn); AT_LOADQ(bqBn, tqBn, vBn); }
        const bool farA = __all(!vA || (tqA - (n * 256 + 255) >= 1513)), farB = __all(!vB || (tqB - (n * 256 + 255) >= 1513));
        const int modeA = ownP ? 0 : (farA ? 2 : 1), modeB = ownP ? 0 : (farB ? 2 : 1);
        const float cbA = modeA == 2 ? biasL[2047] : 0.f, cbB = modeB == 2 ? biasL[2047] : 0.f;
        float mA = -1e30f, mB = -1e30f, lA = 0.f, lB = 0.f;
        f32x4 otA[8], otB[8];
#pragma unroll
        for (int dt = 0; dt < 8; ++dt) { otA[dt] = (f32x4){0.f, 0.f, 0.f, 0.f}; otB[dt] = (f32x4){0.f, 0.f, 0.f, 0.f}; }
#pragma unroll
        for (int ch = 0; ch < 8; ++ch) if (2 * ch < nkt) {
            f32x4 sA[2], sB[2];
#pragma unroll
            for (int k4 = 0; k4 < 2; ++k4) { sA[k4] = (f32x4){0.f, 0.f, 0.f, 0.f}; sB[k4] = (f32x4){0.f, 0.f, 0.f, 0.f};
                if (2 * ch + k4 < nkt) { const unsigned char* ka = lds + AT_K + (16 * (2 * ch + k4) + qi) * 272 + 16 * g4;
#pragma unroll
                    for (int s = 0; s < 4; ++s) { const bf16x8 a = *(const bf16x8*)(ka + 64 * s);
                        sA[k4] = __builtin_amdgcn_mfma_f32_16x16x32_bf16(a, bqA[s], sA[k4], 0, 0, 0); sB[k4] = __builtin_amdgcn_mfma_f32_16x16x32_bf16(a, bqB[s], sB[k4], 0, 0, 0); } } }
            bf16x8 pbA, pbB;
            AT_SOFT(sA, tqA, vA, modeA, mA, lA, otA, pbA);
            AT_SOFT(sB, tqB, vB, modeB, mB, lB, otB, pbB);
            { const unsigned char* va = lds + AT_V + qi * 528 + 64 * ch + 16 * g4;
#pragma unroll
              for (int dt = 0; dt < 8; ++dt) { const bf16x8 a = *(const bf16x8*)(va + dt * 16 * 528);
                  otA[dt] = __builtin_amdgcn_mfma_f32_16x16x32_bf16(a, pbA, otA[dt], 0, 0, 0); otB[dt] = __builtin_amdgcn_mfma_f32_16x16x32_bf16(a, pbB, otB[dt], 0, 0, 0); } }
            __builtin_amdgcn_sched_barrier(0);
        }
        AT_STORE(otA, mA, lA, tqA, slA, vA, cbA);
        AT_STORE(otB, mB, lB, tqB, slB, vB, cbB);
        ownP = false; have = haveN; tqA = tqAn; tqB = tqBn; slA = slAn; slB = slBn; vA = vAn; vB = vBn; nkt = nktN;
#pragma unroll
        for (int s = 0; s < 4; ++s) { bqA[s] = bqAn[s]; bqB[s] = bqBn[s]; }
    }
#undef AT_SOFT
#undef AT_STORE
#undef AT_NEXT
#undef AT_REFILL
#undef AT_LOADQ
    __syncthreads();
}

__device__ __forceinline__ void combine_rows(const Params& p, int m0, int mstep, int lane) {
    bf16_t* proj = (bf16_t*)(p.ws + WS_PROJ);
    const float* ML = (const float*)((const unsigned char*)p.out + DO_ML);
    const int h = lane >> 3, part = lane & 7;
    u32x4 ov[2][2], zv[2][2], pv[2][4][2]; float msv[2][4], lsv[2][4];
#pragma unroll
    for (int r = 0; r < 2; ++r) { const int m = m0 + r * mstep; if (m >= MTOK) continue;
        const int b = m >> 13, t = m & 8191, nv = min(3, t >> 8), bh = b * 8 + h;
        const size_t off = (size_t)m * 1024 + h * 128 + 16 * part;
        const bf16_t* ob = (const bf16_t*)(p.ws + WS_T1) + off; const bf16_t* zb = proj + 3 * SEC + off;
        ov[r][0] = *(const u32x4*)ob; ov[r][1] = *(const u32x4*)(ob + 8); zv[r][0] = *(const u32x4*)zb; zv[r][1] = *(const u32x4*)(zb + 8);
#pragma unroll
        for (int s = 0; s < 4; ++s) { const bool ok = (s == 3) || (s < nv);
            msv[r][s] = -1e30f; lsv[r][s] = 0.f; pv[r][s][0] = (u32x4){0u, 0u, 0u, 0u}; pv[r][s][1] = (u32x4){0u, 0u, 0u, 0u};
            if (ok) { const float* mlp = ML + ((size_t)s * 32 * NT + (size_t)bh * NT + t) * 2; msv[r][s] = mlp[0]; lsv[r][s] = mlp[1];
                const bf16_t* pp = proj + (size_t)(s == 3 ? 6 : s) * SEC + off; pv[r][s][0] = *(const u32x4*)pp; pv[r][s][1] = *(const u32x4*)(pp + 8); } } }
#pragma unroll
    for (int r = 0; r < 2; ++r) { const int m = m0 + r * mstep; if (m >= MTOK) continue;
        {
            const u32x4 o0 = ov[r][0], o1 = ov[r][1], z0 = zv[r][0], z1 = zv[r][1];
            float o[16] = {bflo(o0.x), bfhi(o0.x), bflo(o0.y), bfhi(o0.y), bflo(o0.z), bfhi(o0.z), bflo(o0.w), bfhi(o0.w), bflo(o1.x), bfhi(o1.x), bflo(o1.y), bfhi(o1.y), bflo(o1.z), bfhi(o1.z), bflo(o1.w), bfhi(o1.w)};
            float z[16] = {bflo(z0.x), bfhi(z0.x), bflo(z0.y), bfhi(z0.y), bflo(z0.z), bfhi(z0.z), bflo(z0.w), bfhi(z0.w), bflo(z1.x), bfhi(z1.x), bflo(z1.y), bfhi(z1.y), bflo(z1.z), bfhi(z1.z), bflo(z1.w), bfhi(z1.w)};
            float ss = 0.f;
#pragma unroll
            for (int e = 0; e < 16; ++e) ss += o[e] * o[e];
            ss += __shfl_xor(ss, 1); ss += __shfl_xor(ss, 2); ss += __shfl_xor(ss, 4);
            const float rstd = rsqrtf(ss * (1.f / 128.f) + RMS_EPS);
            const float* ow = p.in[6] + 16 * part;
            float y[16];
#pragma unroll
            for (int e = 0; e < 16; ++e) y[e] = o[e] * rstd * ow[e] * siluf_(z[e]);
            u32x4 w0, w1;
            w0.x = cvt_pk_bf16(y[0], y[1]); w0.y = cvt_pk_bf16(y[2], y[3]); w0.z = cvt_pk_bf16(y[4], y[5]); w0.w = cvt_pk_bf16(y[6], y[7]);
            w1.x = cvt_pk_bf16(y[8], y[9]); w1.y = cvt_pk_bf16(y[10], y[11]); w1.z = cvt_pk_bf16(y[12], y[13]); w1.w = cvt_pk_bf16(y[14], y[15]);
            bf16_t* ya = (bf16_t*)p.out + (size_t)m * 2048 + h * 128 + 16 * part;
            *(u32x4*)ya = w0; *(u32x4*)(ya + 8) = w1;
        }
        {
            float M = -1e30f;
#pragma unroll
            for (int s = 0; s < 4; ++s) M = fmaxf(M, msv[r][s]);
            float acc[16];
#pragma unroll
            for (int e = 0; e < 16; ++e) acc[e] = 0.f;
            float den = 0.f;
#pragma unroll
            for (int s = 0; s < 4; ++s) { const float w = __builtin_amdgcn_exp2f(msv[r][s] - M) * lsv[r][s]; den += w;
                const u32x4 a0 = pv[r][s][0], a1 = pv[r][s][1];
                acc[0] += w * bflo(a0.x); acc[1] += w * bfhi(a0.x); acc[2] += w * bflo(a0.y); acc[3] += w * bfhi(a0.y); acc[4] += w * bflo(a0.z); acc[5] += w * bfhi(a0.z); acc[6] += w * bflo(a0.w); acc[7] += w * bfhi(a0.w);
                acc[8] += w * bflo(a1.x); acc[9] += w * bfhi(a1.x); acc[10] += w * bflo(a1.y); acc[11] += w * bfhi(a1.y); acc[12] += w * bflo(a1.z); acc[13] += w * bfhi(a1.z); acc[14] += w * bflo(a1.w); acc[15] += w * bfhi(a1.w); }
            const float inv = 1.f / den;
            u32x4 w0, w1;
            w0.x = cvt_pk_bf16(acc[0] * inv, acc[1] * inv); w0.y = cvt_pk_bf16(acc[2] * inv, acc[3] * inv); w0.z = cvt_pk_bf16(acc[4] * inv, acc[5] * inv); w0.w = cvt_pk_bf16(acc[6] * inv, acc[7] * inv);
            w1.x = cvt_pk_bf16(acc[8] * inv, acc[9] * inv); w1.y = cvt_pk_bf16(acc[10] * inv, acc[11] * inv); w1.z = cvt_pk_bf16(acc[12] * inv, acc[13] * inv); w1.w = cvt_pk_bf16(acc[14] * inv, acc[15] * inv);
            bf16_t* yb = (bf16_t*)p.out + (size_t)m * 2048 + 1024 + h * 128 + 16 * part;
            *(u32x4*)yb = w0; *(u32x4*)(yb + 8) = w1;
        }
    }
}
__device__ __forceinline__ void grid_bar(unsigned* ctr, unsigned nblocks) {
    asm volatile("s_waitcnt vmcnt(0)" ::: "memory");
    __syncthreads();
    if (threadIdx.x == 0) {
        __builtin_amdgcn_fence(__ATOMIC_RELEASE, "agent");
        asm volatile("s_waitcnt vmcnt(0)" ::: "memory");
        __hip_atomic_fetch_add(ctr, 1u, __ATOMIC_RELAXED, __HIP_MEMORY_SCOPE_AGENT);
        while (__hip_atomic_load(ctr, __ATOMIC_RELAXED, __HIP_MEMORY_SCOPE_AGENT) < nblocks) __builtin_amdgcn_s_sleep(2);
        __builtin_amdgcn_fence(__ATOMIC_ACQUIRE, "agent");
        asm volatile("s_waitcnt vmcnt(0)" ::: "memory");
    }
    __syncthreads();
}
__device__ __forceinline__ void sub_wait(unsigned* ctr, unsigned target) {
    __syncthreads();
    if (threadIdx.x == 0) {
        while (__hip_atomic_load(ctr, __ATOMIC_RELAXED, __HIP_MEMORY_SCOPE_AGENT) < target) __builtin_amdgcn_s_sleep(8);
        __builtin_amdgcn_fence(__ATOMIC_ACQUIRE, "agent");
        asm volatile("s_waitcnt vmcnt(0)" ::: "memory");
    }
    __syncthreads();
}
__global__ void __launch_bounds__(512, 2) fwd_kernel(Params p) {
    extern __shared__ __attribute__((aligned(16))) unsigned char lds[];
    const int tid = threadIdx.x, lane = tid & 63, wave = tid >> 6;
    const int G = gridDim.x, bid = blockIdx.x;
    unsigned char* ws = p.ws; unsigned char* dob = (unsigned char*)p.out;
    bf16_t* proj = (bf16_t*)(ws + WS_PROJ);
    PG8_LAS unsigned char* ldsa = (PG8_LAS unsigned char*)lds;
    const int lo = p.ph_lo, hi = p.ph_hi;
#ifdef PH_MASK
#define IN(k) (((PH_MASK >> (k)) & 1) && lo <= (k) && (k) < hi)
#else
#define IN(k) (lo <= (k) && (k) < hi)
#endif
#define SEAM(k) do { if (IN(k) && IN((k) + 1)) { if ((k) == 0) cg::this_grid().sync(); else grid_bar((unsigned*)(ws + WS_CNT) + 64 * (k), (unsigned)G); } } while (0)

    if (IN(0)) { phase0(p, lds); }
    SEAM(0);
    if (IN(1)) {
        pg8::Gemm g{(const bf16_t*)dob, (const bf16_t*)(ws + WS_WIN), MTOK, NPROJ, DM}; pg8::StaticOrder S; S.init(MTOK, NPROJ, G, bid);
        pg8::EpiSplit E{proj};
        pg8::gemm_phase<pg8::EpiSplit, pg8::StaticOrder, true, true>(ldsa, g, S, E);
    }
    SEAM(1);
    if (IN(2)) {
        for (int base = bid * 16; base < 4096; base += G * 16) {
            const int hh = (base >> 7) & 7; float* cwl = (float*)(lds + GP_CW);
            for (int i = tid; i < 1536; i += 512) { const int j = i / 384, r = i % 384; cwl[i] = p.in[3][j * 3072 + (r >> 7) * 1024 + hh * 128 + (r & 127)]; }
            u32x4 raw[3][2][4]; float gpre = 0.f, bpre = 0.f;
            GP_ISSUE(raw, gpre, bpre, base);
            for (int k = 0; k < 16; ++k) gdn_prep_item(p, lds, base + k, raw, gpre, bpre, k < 15 ? base + k + 1 : -1);
            __syncthreads();
        }
    }
    SEAM(2);
    if (IN(3)) {
        unsigned* cnt = (unsigned*)(ws + WS_CNT) + 16 * (p.flags >> 8);
        const unsigned NM = (unsigned)(G - 32);
        if (bid < 32) {
            if (!(p.flags & 4)) scan_bh(p, lds, bid);
            sub_wait(cnt + 8, NM);
        } else {
            if (!(p.flags & 1)) for (int it = bid - 32; it < 1024; it += G - 32) moba_prep_item(p, lds, it);
            grid_bar(cnt + 4, NM);
            float* sc = (float*)(lds + wave * 4352);
            for (int it = (bid - 32) * 8 + wave; it < 32 * 256; it += (G - 32) * 8) route_item(p, sc, it, lane);
            grid_bar(cnt + 8, NM);
        }
        volatile int* misc = (volatile int*)(lds + AT_MISC);
        for (;;) {
            if (tid == 0) misc[0] = (int)atomicAdd(cnt, 1u);
            __syncthreads();
            const int it = misc[0];
            __syncthreads();
            if (it >= 1024 || (p.flags & 8)) break;
            attn_item(p, lds, it);
        }
        if (bid >= 32 && !(p.flags >> 8)) {
            float* scr = (float*)(lds + wave * 8704);
            constexpr int I_B = 16 * 64, I_O = 32 * 64, I_GU = 32 * 352, I_DN = 88 * 64;
            for (int itw = (bid - 32) * 8 + wave; itw < 2 * I_B + I_O + I_GU + I_DN; itw += (G - 32) * 8) {
                int r = itw;
                if (r < I_B) { const int kb = r / 64, nb = r % 64;
                    transpose_item(p.in[10] + (size_t)(64 * kb) * 2048 + 32 * nb, 2048, (bf16_t*)(ws + WS_WBG) + (size_t)(32 * nb) * 2048 + 64 * kb, 2048, nullptr, scr, lane); continue; } r -= I_B;
                if (r < I_B) { const int kb = r / 64, nb = r % 64;
                    transpose_item(p.in[11] + (size_t)(64 * kb) * 2048 + 32 * nb, 2048, (bf16_t*)(ws + WS_WBG) + (size_t)(32 * nb) * 2048 + 1024 + 64 * kb, 2048, nullptr, scr, lane); continue; } r -= I_B;
                if (r < I_O) { const int kb = r / 64, nb = r % 64;
                    transpose_item(p.in[12] + (size_t)(64 * kb) * 2048 + 32 * nb, 2048, (bf16_t*)(ws + WS_WOUT) + (size_t)(32 * nb) * 2048 + 64 * kb, 2048, nullptr, scr, lane); continue; } r -= I_O;
                if (r < I_GU) { const int kb = r / 352, nb = r % 352, n0 = 32 * nb, pn = n0 >> 8, bj = (n0 >> 7) & 1, j0 = n0 & 127;
                    const float* W = bj ? p.in[15] : p.in[14];
                    transpose_item(W + (size_t)(64 * kb) * DFF + 128 * pn + j0, DFF, (bf16_t*)(ws + WS_WGU) + (size_t)n0 * 2048 + 64 * kb, 2048, p.in[13] + 64 * kb, scr, lane); }
                else { r -= I_GU; const int kb = r / 64, nb = r % 64;
                    transpose_item(p.in[16] + (size_t)(64 * kb) * 2048 + 32 * nb, 2048, (bf16_t*)(ws + WS_WDN) + (size_t)(32 * nb) * DFF + 64 * kb, DFF, nullptr, scr, lane); }
            }
        }
    }
    SEAM(3);
    if (IN(4)) {
        for (int m = bid * 8 + wave; m < MTOK; m += 2 * G * 8) combine_rows(p, m, G * 8, lane);
    }
    SEAM(4);
    if (IN(5)) {
        pg8::Gemm g{(const bf16_t*)dob, (const bf16_t*)(ws + WS_WBG), MTOK, DM, DM}; pg8::StaticOrder S; S.init(MTOK, DM, G, bid);
        pg8::EpiGateMix E{proj + 7 * SEC, proj};
        pg8::gemm_phase<pg8::EpiGateMix, pg8::StaticOrder, true, true>(ldsa, g, S, E);
    }
    SEAM(5);
    if (IN(6)) {
        pg8::Gemm g{proj, (const bf16_t*)(ws + WS_WOUT), MTOK, DM, DM}; pg8::StaticOrder S; S.init(MTOK, DM, G, bid);
        pg8::EpiH1 E{p.in[0], p.out, proj + 5 * SEC, (float*)(ws + WS_MISC)};
        pg8::gemm_phase<pg8::EpiH1, pg8::StaticOrder, true, true>(ldsa, g, S, E);
    }
    SEAM(6);
    if (IN(7)) {
        pg8::Gemm g{proj + 5 * SEC, (const bf16_t*)(ws + WS_WGU), MTOK, NPROJ, DM}; pg8::StaticOrder S; S.init(MTOK, NPROJ, G, bid);
        pg8::EpiSwiGLU E{(const float*)(ws + WS_MISC), proj + 7 * SEC};
        pg8::gemm_phase<pg8::EpiSwiGLU, pg8::StaticOrder, true, true>(ldsa, g, S, E);
    }
    SEAM(7);
    if (IN(8)) {
        pg8::Gemm g{proj + 7 * SEC, (const bf16_t*)(ws + WS_WDN), MTOK, DM, DFF}; pg8::StaticOrder S; S.init(MTOK, DM, G, bid);
        pg8::EpiDown E{p.out};
        pg8::gemm_phase<pg8::EpiDown, pg8::StaticOrder, true, true>(ldsa, g, S, E);
    }
#undef IN
#undef SEAM
}

extern "C" void kernel_launch(void* const* d_in, const int* in_sizes, int n_in, void* d_out, int out_size, void* d_ws, size_t ws_size, hipStream_t stream) {
    static int grid = 0;
    if (grid == 0) {
        if (n_in != 17 || out_size != MTOK * DM || ws_size < 16 * SECB) { fprintf(stderr, "kernel_launch: unexpected shapes (n_in %d out %d ws %zu)\n", n_in, out_size, ws_size); grid = -1; return; }
        int dev = 0, cus = 0, per_cu = 0;
        hipGetDevice(&dev); hipDeviceGetAttribute(&cus, hipDeviceAttributeMultiprocessorCount, dev);
        if (hipFuncSetAttribute((const void*)fwd_kernel, hipFuncAttributeMaxDynamicSharedMemorySize, LDS_BYTES) != hipSuccess) { fprintf(stderr, "kernel_launch: hipFuncSetAttribute failed\n"); grid = -1; return; }
        if (hipOccupancyMaxActiveBlocksPerMultiprocessor(&per_cu, (const void*)fwd_kernel, 512, LDS_BYTES) != hipSuccess || per_cu < 1) { fprintf(stderr, "kernel_launch: occupancy query says %d\n", per_cu); per_cu = 1; }
        (void)hipGetLastError();
        grid = cus * 1;
    }
    if (grid < 0) return;
    Params p{};
    for (int i = 0; i < 17; ++i) p.in[i] = (const float*)d_in[i];
    p.out = (float*)d_out; p.ws = (unsigned char*)d_ws;
    static const int prog[][3] = LAUNCH_PROG;
    for (unsigned i = 0; i < sizeof(prog) / sizeof(prog[0]); ++i) {
        p.ph_lo = prog[i][0]; p.ph_hi = prog[i][1]; p.flags = prog[i][2];
        void* args[] = {&p};
        hipError_t e = hipLaunchCooperativeKernel((const void*)fwd_kernel, dim3(grid), dim3(512), args, LDS_BYTES, stream);
        if (e != hipSuccess) fprintf(stderr, "cooperative launch failed: %s (grid %d)\n", hipGetErrorString(e), grid);
    }
}
```
